# Optimizing an MI355X kernel written in HIP

```python
import math
import jax, jax.numpy as jnp
from jax import lax
import numpy as np

D_MODEL = 1024
BATCH = 16
SEQ = 4096
DEPTH = 4

MEM_LEN = 256
CONV_CH = D_MODEL // 4
CONV_WIDTH = 31
CONV_PAD = (CONV_WIDTH - 1) // 2
DIFF_HEADS = 4
DIFF_W = D_MODEL // 2
DIFF_DV = DIFF_W // DIFF_HEADS
DIFF_DH = DIFF_DV // 2
DIFF_QK_W = DIFF_HEADS * 2 * DIFF_DH
MEM_HEADS = 4
MEM_W = D_MODEL // 4
MEM_DH = MEM_W // MEM_HEADS
MIX_W = CONV_CH + DIFF_W + MEM_W
IN_W = 2 * CONV_CH + 2 * DIFF_QK_W + DIFF_W + MEM_W
D_FF = 4 * D_MODEL
N_BUCKETS = 32
MAX_DISTANCE = 128
Q_BLOCK = 128
ALPHA = (2.0 * DEPTH) ** 0.25
BETA = (8.0 * DEPTH) ** -0.25
LN_EPS = 1e-5

kernel_name = "hybrid_conformer_diffattn_memory_encoder"


def layer_norm(x, g, b):
    xf = x.astype(jnp.float32)
    mu = jnp.mean(xf, axis=-1, keepdims=True)
    var = jnp.mean(jnp.square(xf - mu), axis=-1, keepdims=True)
    y = (xf - mu) * lax.rsqrt(var + LN_EPS) * g.astype(jnp.float32) + b.astype(jnp.float32)
    return y.astype(x.dtype)


def t5_bucket(rel):
    half = N_BUCKETS // 2
    max_exact = half // 2
    ret = (rel > 0).astype(jnp.int32) * half
    n = jnp.abs(rel)
    nf = jnp.maximum(n, 1).astype(jnp.float32)
    large = max_exact + (jnp.log(nf / max_exact) / math.log(MAX_DISTANCE / max_exact)
                         * (half - max_exact)).astype(jnp.int32)
    large = jnp.minimum(large, half - 1)
    return ret + jnp.where(n < max_exact, n, large)


def relative_bias_offsets(rel_bias, seq):
    offsets = jnp.arange(-(seq - 1), seq, dtype=jnp.int32)
    return rel_bias[t5_bucket(offsets)].T.astype(jnp.float32)


def conformer_conv(c_in, conv_w, conv_b, ln_g, ln_b):
    a, gate = jnp.split(c_in, 2, axis=-1)
    u = a * jax.nn.sigmoid(gate)
    y = lax.conv_general_dilated(
        u, conv_w[:, None, :], window_strides=(1,), padding=[(CONV_PAD, CONV_PAD)],
        dimension_numbers=("NWC", "WIO", "NWC"), feature_group_count=CONV_CH) + conv_b
    return jax.nn.silu(layer_norm(y, ln_g, ln_b))


def diff_attention(q, k, v, bias_off, lq1, lk1, lq2, lk2, lam_init, norm_g):
    B, S, _ = q.shape
    H, dh, dv = DIFF_HEADS, DIFF_DH, DIFF_DV
    q = q.reshape(B, S, H, 2, dh)
    k = k.reshape(B, S, H, 2, dh)
    q1 = q[..., 0, :].transpose(0, 2, 1, 3)
    q2 = q[..., 1, :].transpose(0, 2, 1, 3)
    k1 = k[..., 0, :].transpose(0, 2, 1, 3)
    k2 = k[..., 1, :].transpose(0, 2, 1, 3)
    vh = v.reshape(B, S, H, dv).transpose(0, 2, 1, 3)
    lam = (jnp.exp(jnp.sum(lq1.astype(jnp.float32) * lk1.astype(jnp.float32)))
           - jnp.exp(jnp.sum(lq2.astype(jnp.float32) * lk2.astype(jnp.float32)))
           + lam_init)
    scale = dh ** -0.5
    nb = S // Q_BLOCK
    kpos = jnp.arange(S, dtype=jnp.int32)

    def to_blocks(t):
        return t.reshape(B, H, nb, Q_BLOCK, t.shape[-1]).transpose(2, 0, 1, 3, 4)

    def block(args):
        q1b, q2b, start = args
        qpos = start + jnp.arange(Q_BLOCK, dtype=jnp.int32)
        bias = bias_off[:, kpos[None, :] - qpos[:, None] + S - 1]
        s1 = jnp.einsum("bhqd,bhkd->bhqk", q1b, k1).astype(jnp.float32) * scale + bias
        s2 = jnp.einsum("bhqd,bhkd->bhqk", q2b, k2).astype(jnp.float32) * scale + bias
        attn = jax.nn.softmax(s1, axis=-1) - lam * jax.nn.softmax(s2, axis=-1)
        return jnp.einsum("bhqk,bhkd->bhqd", attn.astype(vh.dtype), vh)

    starts = jnp.arange(nb, dtype=jnp.int32) * Q_BLOCK
    o = lax.map(block, (to_blocks(q1), to_blocks(q2), starts))
    o = o.transpose(1, 0, 3, 2, 4).reshape(B, S, H, dv)
    of = o.astype(jnp.float32)
    of = of * lax.rsqrt(jnp.mean(jnp.square(of), axis=-1, keepdims=True) + LN_EPS)
    of = of * norm_g.astype(jnp.float32) * (1.0 - lam_init)
    return of.astype(q.dtype).reshape(B, S, DIFF_W)


def memory_attention(qm, mem, w_mem_kv):
    B, S, _ = qm.shape
    M = mem.shape[1]
    qh = qm.reshape(B, S, MEM_HEADS, MEM_DH)
    km, vm = jnp.split(mem @ w_mem_kv, 2, axis=-1)
    km = km.reshape(B, M, MEM_HEADS, MEM_DH)
    vm = vm.reshape(B, M, MEM_HEADS, MEM_DH)
    s = jnp.einsum("bshd,bmhd->bhsm", qh, km).astype(jnp.float32) * (MEM_DH ** -0.5)
    p = jax.nn.softmax(s, axis=-1).astype(vm.dtype)
    return jnp.einsum("bhsm,bmhd->bshd", p, vm).reshape(B, S, MEM_W)


def hybrid_mixer(h, mem, bias_off, w_in, b_in, conv_w, conv_b, conv_ln_g, conv_ln_b,
                 lq1, lk1, lq2, lk2, lam_init, diff_norm_g, w_mem_kv, w_out, b_out):
    proj = h @ w_in + b_in
    s0 = 2 * CONV_CH
    s1 = s0 + DIFF_QK_W
    s2 = s1 + DIFF_QK_W
    s3 = s2 + DIFF_W
    c_in, q, k, v, qm = jnp.split(proj, [s0, s1, s2, s3], axis=-1)
    conv_out = conformer_conv(c_in, conv_w, conv_b, conv_ln_g, conv_ln_b)
    diff_out = diff_attention(q, k, v, bias_off, lq1, lk1, lq2, lk2, lam_init, diff_norm_g)
    mem_out = memory_attention(qm, mem, w_mem_kv)
    mixed = jnp.concatenate([conv_out, diff_out, mem_out], axis=-1)
    return mixed @ w_out + b_out


def setup_inputs(seed: int = 0) -> dict:
    key = jax.random.key(seed)
    ks = jax.random.split(key, 32)
    L, D = DEPTH, D_MODEL
    nrm = jax.random.normal
    f32 = jnp.float32
    return {
        "x": nrm(ks[0], (BATCH, SEQ, D), f32),
        "mem": nrm(ks[1], (BATCH, MEM_LEN, D), f32),
        "emb_ln_g": 1.0 + 0.02 * nrm(ks[2], (D,), f32),
        "emb_ln_b": 0.02 * nrm(ks[3], (D,), f32),
        "rel_bias": 0.5 * nrm(ks[4], (N_BUCKETS, DIFF_HEADS), f32),
        "w_in": nrm(ks[5], (L, D, IN_W), f32) * D ** -0.5,
        "b_in": 0.02 * nrm(ks[6], (L, IN_W), f32),
        "conv_w": nrm(ks[7], (L, CONV_WIDTH, CONV_CH), f32) * CONV_WIDTH ** -0.5,
        "conv_b": 0.02 * nrm(ks[8], (L, CONV_CH), f32),
        "conv_ln_g": 1.0 + 0.02 * nrm(ks[9], (L, CONV_CH), f32),
        "conv_ln_b": 0.02 * nrm(ks[10], (L, CONV_CH), f32),
        "lambda_q1": 0.1 * nrm(ks[11], (L, DIFF_DH), f32),
        "lambda_k1": 0.1 * nrm(ks[12], (L, DIFF_DH), f32),
        "lambda_q2": 0.1 * nrm(ks[13], (L, DIFF_DH), f32),
        "lambda_k2": 0.1 * nrm(ks[14], (L, DIFF_DH), f32),
        "diff_norm_g": 1.0 + 0.02 * nrm(ks[15], (L, DIFF_DV), f32),
        "w_mem_kv": nrm(ks[16], (L, D, 2 * MEM_W), f32) * D ** -0.5,
        "w_out": nrm(ks[17], (L, MIX_W, D), f32) * (MIX_W ** -0.5) * BETA,
        "b_out": 0.02 * nrm(ks[18], (L, D), f32),
        "ln1_g": 1.0 + 0.02 * nrm(ks[19], (L, D), f32),
        "ln1_b": 0.02 * nrm(ks[20], (L, D), f32),
        "w_up": nrm(ks[21], (L, D, D_FF), f32) * D ** -0.5,
        "w_down": nrm(ks[22], (L, D_FF, D), f32) * (D_FF ** -0.5) * BETA,
        "ln2_g": 1.0 + 0.02 * nrm(ks[23], (L, D), f32),
        "ln2_b": 0.02 * nrm(ks[24], (L, D), f32),
    }


def reference(x, mem, emb_ln_g, emb_ln_b, rel_bias, w_in, b_in, conv_w, conv_b,
              conv_ln_g, conv_ln_b, lambda_q1, lambda_k1, lambda_q2, lambda_k2,
              diff_norm_g, w_mem_kv, w_out, b_out, ln1_g, ln1_b, w_up, w_down,
              ln2_g, ln2_b):
    S = x.shape[1]
    x = layer_norm(x, emb_ln_g, emb_ln_b)
    bias_off = relative_bias_offsets(rel_bias, S)
    for l in range(DEPTH):
        lam_init = 0.8 - 0.6 * math.exp(-0.3 * l)
        mixed = hybrid_mixer(x, mem, bias_off, w_in[l], b_in[l], conv_w[l], conv_b[l],
                             conv_ln_g[l], conv_ln_b[l], lambda_q1[l], lambda_k1[l],
                             lambda_q2[l], lambda_k2[l], lam_init, diff_norm_g[l],
                             w_mem_kv[l], w_out[l], b_out[l])
        x = layer_norm(ALPHA * x + mixed, ln1_g[l], ln1_b[l])
        ff = jnp.square(jax.nn.relu(x @ w_up[l])) @ w_down[l]
        x = layer_norm(ALPHA * x + ff, ln2_g[l], ln2_b[l])
    return x
```

```cpp
#include <hip/hip_runtime.h>
#include <hip/hip_cooperative_groups.h>
#include <cstdio>
#include <cstdint>
#include <cmath>
namespace cg = cooperative_groups;

#define LAS __attribute__((address_space(3)))
typedef unsigned short bf16_t;
typedef short bf16x8 __attribute__((ext_vector_type(8)));
typedef short s16x4 __attribute__((ext_vector_type(4)));
typedef float f32x4 __attribute__((ext_vector_type(4)));
typedef float f32x2 __attribute__((ext_vector_type(2)));
typedef float f32x16 __attribute__((ext_vector_type(16)));
typedef unsigned u32x4 __attribute__((ext_vector_type(4)));
typedef unsigned u32x2 __attribute__((ext_vector_type(2)));

constexpr int BATCH = 16, SEQ = 4096, DM = 1024, DEPTH = 4, MEML = 256, INW = 2304, FF = 4096;
constexpr int MTOK = BATCH * SEQ;
constexpr int MMEM = BATCH * MEML;
constexpr int CONVC = 256, CONVW = 31;
constexpr float ALPHA = 1.6817928305074290f;
constexpr float LN_EPS = 1e-5f;
constexpr float LOG2E = 1.4426950408889634f;
constexpr float QSCALE = 0.125f * LOG2E;
constexpr int NWAVES = 8;

constexpr size_t MiB = 1u << 20;
constexpr size_t WS_WIN = 0;
constexpr size_t WS_WOUT = 18 * MiB;
constexpr size_t WS_WUP = 26 * MiB;
constexpr size_t WS_WDN = 58 * MiB;
constexpr size_t WS_WMKV = 90 * MiB;
constexpr size_t WS_MEMB = 94 * MiB;
constexpr size_t WS_MEMKV = 102 * MiB;
constexpr size_t WS_XB = 120 * MiB;
constexpr size_t WS_H = 248 * MiB;
constexpr size_t WS_PROJ = 248 * MiB;
constexpr size_t WS_MIXED = 536 * MiB;
constexpr size_t WS_END = 760 * MiB;

constexpr int LDS_BYTES = 139264;

__device__ __forceinline__ unsigned cvt_pk_bf16(float lo, float hi) { unsigned r; asm volatile("v_cvt_pk_bf16_f32 %0, %1, %2" : "=v"(r) : "v"(lo), "v"(hi)); return r; }
__device__ __forceinline__ float bf2f(unsigned short b) { return __uint_as_float(((unsigned)b) << 16); }
__device__ __forceinline__ int opaque_tid() { int t = threadIdx.x; asm volatile("" : "+v"(t)); return t; }
__device__ __forceinline__ float wave_sum(float v) {
#pragma unroll
    for (int o = 1; o < 64; o <<= 1) v += __shfl_xor(v, o);
    return v;
}

namespace pg8 {
constexpr int BM = 256, BK = 64, HALF = 128, HTB = HALF * BK * 2, STAGE_BYTES = 8 * HTB, NXCD = 8, WGM = 8;
__host__ __device__ __forceinline__ int lds_byte(int r, int c) { const int st = (r >> 4) * 2 + (c >> 5), rr = r & 15, cc = c & 31, ob = rr * 64 + cc * 2; return st * 1024 + (ob ^ (((ob >> 9) & 1) << 5)); }
__host__ __device__ __forceinline__ void stage_rc(int b, int& R, int& C) { const int st = b / 1024, sb = b % 1024, swz = sb ^ (((sb >> 9) & 1) << 5); R = (st >> 1) * 16 + swz / 64; C = (st & 1) * 32 + (swz % 64) / 2; }
__host__ __device__ __forceinline__ int perm32(int rho) { const int n = rho >> 4, i = rho & 15; return 8 * (i >> 2) + 4 * n + (i & 3); }

struct Unit { int pm, pn; };
struct Gemm { const bf16_t* A; const bf16_t* Bt; int M, N, K; };

struct StaticOrder {
    int nM, nN, nwg, G, c;
    __host__ __device__ void init(int M, int N, int G_, int c_) { nM = M / BM; nN = N / BM; nwg = nM * nN; G = G_; c = c_; }
    __host__ __device__ bool next(int i, Unit& u) const {
        const long L = (long)i * G + c; if (L >= nwg) return false;
        int wgid = (int)L; { const int q = nwg / NXCD, r = nwg % NXCD, xcd = wgid % NXCD, off = wgid / NXCD; wgid = (xcd < r ? xcd * (q + 1) : r * (q + 1) + (xcd - r) * q) + off; }
        const int nig = WGM * nN, gid = wgid / nig, fm = gid * WGM, gsz = (nM - fm) < WGM ? (nM - fm) : WGM;
        u.pm = fm + ((wgid % nig) % gsz); u.pn = (wgid % nig) / gsz; return true;
    }
};

template <int MODE> struct EpiStore {
    static constexpr bool PERM = true;
    bf16_t* O; int ldc; const float* bias;
    __device__ __forceinline__ void operator()(const f32x4 (&acc)[2][2][4][2], const Unit& u, int wr, int wc, int fr, int fq) const {
        const int row0 = u.pm * BM + wr * 64 + fr; const int col0 = u.pn * BM + wc * 32 + 8 * fq;
        float sc = 1.f; if (MODE == 1) { if (u.pn == 2 || u.pn == 3 || u.pn == 8) sc = QSCALE; }
        f32x4 bv[2][2];
#pragma unroll
        for (int bj = 0; bj < 2; ++bj)
#pragma unroll
            for (int n = 0; n < 2; ++n) bv[bj][n] = (MODE == 1) ? *(const f32x4*)(bias + col0 + bj * HALF + 4 * n) : (f32x4){0.f, 0.f, 0.f, 0.f};
#pragma unroll
        for (int ai = 0; ai < 2; ++ai)
#pragma unroll
            for (int m = 0; m < 4; ++m) { bf16_t* rowp = O + (size_t)(row0 + ai * HALF + m * 16) * ldc + col0;
#pragma unroll
                for (int bj = 0; bj < 2; ++bj) { f32x4 v0 = acc[ai][bj][m][0] + bv[bj][0], v1 = acc[ai][bj][m][1] + bv[bj][1];
                    if (MODE == 2) { v0 = __builtin_elementwise_max(v0, (f32x4){0.f, 0.f, 0.f, 0.f}); v1 = __builtin_elementwise_max(v1, (f32x4){0.f, 0.f, 0.f, 0.f}); v0 = v0 * v0; v1 = v1 * v1; }
                    if (MODE == 1) { v0 = v0 * sc; v1 = v1 * sc; }
                    u32x4 w; w.x = cvt_pk_bf16(v0[0], v0[1]); w.y = cvt_pk_bf16(v0[2], v0[3]); w.z = cvt_pk_bf16(v1[0], v1[1]); w.w = cvt_pk_bf16(v1[2], v1[3]);
                    *(u32x4*)(rowp + bj * HALF) = w; } }
    }
};
struct EpiResid {
    static constexpr bool PERM = false;
    float* X; const float* bias;
    __device__ __forceinline__ void operator()(const f32x4 (&acc)[2][2][4][2], const Unit& u, int wr, int wc, int fr, int fq) const {
        const int col0 = u.pn * BM + wc * 32 + 4 * fq;
        f32x4 bv[2][2];
#pragma unroll
        for (int bj = 0; bj < 2; ++bj)
#pragma unroll
            for (int n = 0; n < 2; ++n) bv[bj][n] = bias ? *(const f32x4*)(bias + col0 + bj * HALF + n * 16) : (f32x4){0.f, 0.f, 0.f, 0.f};
#pragma unroll
        for (int ai = 0; ai < 2; ++ai)
#pragma unroll
            for (int m = 0; m < 4; ++m) { float* rp = X + (size_t)(u.pm * BM + ai * HALF + wr * 64 + m * 16 + fr) * DM + col0;
#pragma unroll
                for (int bj = 0; bj < 2; ++bj)
#pragma unroll
                    for (int n = 0; n < 2; ++n) { const f32x4 x = *(const f32x4*)(rp + bj * HALF + n * 16); *(f32x4*)(rp + bj * HALF + n * 16) = x * ALPHA + acc[ai][bj][m][n] + bv[bj][n]; }
                if (m & 1) asm volatile("" ::: "memory"); }
    }
};

template <class Epi, class Sched>
__device__ __forceinline__ void gemm_phase(LAS unsigned char* lds, const Gemm g, const Sched& S, const Epi& E) {
    const int tid = opaque_tid(), wid = __builtin_amdgcn_readfirstlane(tid >> 6), lane = tid & 63, wr = wid >> 2, wc = wid & 3, fr = lane & 15, fq = lane >> 4;
    const int K = g.K, nt = K / BK;
    unsigned voffA[2], voffB[2];
#pragma unroll
    for (int i = 0; i < 2; ++i) { int R, C; stage_rc(tid * 16 + i * 8192, R, C); const int Rb = Epi::PERM ? ((R & ~31) + perm32(R & 31)) : R;
        voffA[i] = (unsigned)(R * K + C) * 2u; voffB[i] = (unsigned)(Rb * K + C) * 2u; }
    const size_t kstep = (size_t)(BK * 2);
    const size_t hstep = (size_t)HALF * K * 2;
    const size_t tstep = 2 * hstep;
    const unsigned ldsw = (unsigned)wid * 1024u;
    const int aoff = lds_byte(wr * 64 + fr, fq * 8), boff = lds_byte(wc * 32 + fr, fq * 8);
#define PG8_SA(b, h) (((b) * 2 + (h)) * HTB)
#define PG8_SB(b, h) ((4 + (b) * 2 + (h)) * HTB)
#define PG8_STAGE(bufoff, gbase, voff) do { _Pragma("unroll") for (int _i = 0; _i < 2; ++_i) \
        __builtin_amdgcn_global_load_lds((const unsigned*)((const char*)(gbase) + (voff)[_i]), (LAS unsigned*)(lds + (bufoff) + ldsw + _i * 8192), 16, 0, 0); } while (0)
#define PG8_LDA(dst, b, h) do { _Pragma("unroll") for (int m = 0; m < 4; ++m) _Pragma("unroll") for (int k = 0; k < 2; ++k) dst[m][k] = *(const LAS bf16x8*)(lds + PG8_SA(b, h) + aoff + m * 2048 + k * 1024); } while (0)
#define PG8_LDB(dst, b, h) do { _Pragma("unroll") for (int n = 0; n < 2; ++n) _Pragma("unroll") for (int k = 0; k < 2; ++k) dst[n][k] = *(const LAS bf16x8*)(lds + PG8_SB(b, h) + boff + n * 2048 + k * 1024); } while (0)
#define PG8_MMA(ai, bj, At, Bt) do { __builtin_amdgcn_s_setprio(1); _Pragma("unroll") for (int m = 0; m < 4; ++m) _Pragma("unroll") for (int n = 0; n < 2; ++n) _Pragma("unroll") for (int k = 0; k < 2; ++k) \
        acc[ai][bj][m][n] = __builtin_amdgcn_mfma_f32_16x16x32_bf16(Bt[n][k], At[m][k], acc[ai][bj][m][n], 0, 0, 0); __builtin_amdgcn_s_setprio(0); } while (0)
#define PG8_WAIT_V(n) asm volatile("s_waitcnt vmcnt(" #n ")" ::: "memory")
#define PG8_WAIT_L(n) asm volatile("s_waitcnt lgkmcnt(" #n ")" ::: "memory")
#define PG8_BAR __builtin_amdgcn_s_barrier()
#define PG8_SCHED __builtin_amdgcn_sched_barrier(0)
    Unit cur, nxt; int ui = 0;
    if (!S.next(0, cur)) return;
    f32x4 acc[2][2][4][2];
#pragma unroll
    for (int a = 0; a < 2; ++a)
#pragma unroll
        for (int b = 0; b < 2; ++b)
#pragma unroll
            for (int m = 0; m < 4; ++m)
#pragma unroll
                for (int n = 0; n < 2; ++n) acc[a][b][m][n] = (f32x4){0.f, 0.f, 0.f, 0.f};
    bf16x8 At[4][2], B0[2][2], B1[2][2];
    const char* cA = (const char*)g.A + (size_t)cur.pm * tstep; const char* cB = (const char*)g.Bt + (size_t)cur.pn * tstep;
    PG8_STAGE(PG8_SB(0, 0), cB, voffB); PG8_STAGE(PG8_SB(0, 1), cB + hstep, voffB); PG8_STAGE(PG8_SA(0, 0), cA, voffA); PG8_STAGE(PG8_SA(0, 1), cA + hstep, voffA);
    if (wr == 1) PG8_BAR;
    PG8_WAIT_V(2); PG8_BAR;
    PG8_STAGE(PG8_SB(1, 0), cB + kstep, voffB); PG8_STAGE(PG8_SA(1, 0), cA + kstep, voffA); PG8_STAGE(PG8_SB(1, 1), cB + hstep + kstep, voffB);
    PG8_WAIT_V(6); PG8_BAR;
    for (;;) {
        const bool has_next = S.next(ui + 1, nxt);
        const char* nA = has_next ? (const char*)g.A + (size_t)nxt.pm * tstep : cA; const char* nB = has_next ? (const char*)g.Bt + (size_t)nxt.pn * tstep : cB;
        for (int t = 0; t < nt; t += 2) {
            const bool last = (t == nt - 2);
            const char* a1 = cA + (size_t)(t + 1) * kstep;
            const char* a2 = last ? nA : cA + (size_t)(t + 2) * kstep; const char* b2 = last ? nB : cB + (size_t)(t + 2) * kstep;
            const char* a3 = a2 + kstep; const char* b3 = b2 + kstep;
            PG8_LDB(B0, 0, 0); PG8_LDB(B1, 0, 1); PG8_SCHED; PG8_LDA(At, 0, 0); PG8_STAGE(PG8_SA(1, 1), a1 + hstep, voffA);
            PG8_WAIT_V(8); PG8_WAIT_L(0); PG8_BAR; PG8_MMA(0, 0, At, B0); PG8_MMA(0, 1, At, B1); PG8_BAR; PG8_SCHED;
            PG8_LDA(At, 0, 1); PG8_STAGE(PG8_SB(0, 0), b2, voffB); PG8_STAGE(PG8_SB(0, 1), b2 + hstep, voffB); PG8_STAGE(PG8_SA(0, 0), a2, voffA);
            PG8_WAIT_V(8); PG8_WAIT_L(0); PG8_BAR; PG8_MMA(1, 0, At, B0); PG8_MMA(1, 1, At, B1); PG8_BAR; PG8_SCHED;
            PG8_LDB(B0, 1, 0); PG8_LDB(B1, 1, 1); PG8_SCHED; PG8_LDA(At, 1, 0); PG8_STAGE(PG8_SA(0, 1), a2 + hstep, voffA);
            PG8_WAIT_V(8); PG8_WAIT_L(0); PG8_BAR; PG8_MMA(0, 0, At, B0); PG8_MMA(0, 1, At, B1); PG8_BAR; PG8_SCHED;
            PG8_LDA(At, 1, 1); PG8_STAGE(PG8_SB(1, 0), b3, voffB); PG8_STAGE(PG8_SB(1, 1), b3 + hstep, voffB); PG8_STAGE(PG8_SA(1, 0), a3, voffA);
            PG8_WAIT_V(8); PG8_WAIT_L(0); PG8_BAR; PG8_MMA(1, 0, At, B0); PG8_MMA(1, 1, At, B1); PG8_BAR; PG8_SCHED;
        }
        if (wr == 0) PG8_BAR;
        E(acc, cur, wr, wc, fr, fq);
        if (!has_next) break;
#pragma unroll
        for (int a = 0; a < 2; ++a)
#pragma unroll
            for (int b = 0; b < 2; ++b)
#pragma unroll
                for (int m = 0; m < 4; ++m)
#pragma unroll
                    for (int n = 0; n < 2; ++n) acc[a][b][m][n] = (f32x4){0.f, 0.f, 0.f, 0.f};
        cur = nxt; cA = nA; cB = nB; ++ui;
        if (wr == 1) PG8_BAR;
    }
    PG8_WAIT_V(0);
    PG8_BAR;
#undef PG8_SA
#undef PG8_SB
#undef PG8_STAGE
#undef PG8_LDA
#undef PG8_LDB
#undef PG8_MMA
#undef PG8_WAIT_V
#undef PG8_WAIT_L
#undef PG8_BAR
#undef PG8_SCHED
}
}

namespace att {
constexpr int KVBLK = 64;
constexpr int SHM_V = 16384, SHM_K = 16384;
constexpr int L_V = 0, L_K = 32768, L_WS = 65536, L_TAB = 67584, L_EX = 73728;
constexpr int TABN = 373, TABC = 186;
constexpr float THR = 8.f;
#define KSWZ(row, colB) ((row) * 256 + ((colB) ^ (((row) & 15) << 4)))
#define SBAR() __builtin_amdgcn_sched_barrier(0)
__device__ __forceinline__ int crow(int r, int hi) { return (r & 3) + 8 * (r >> 2) + 4 * hi; }

__device__ __forceinline__ void partialSM(f32x16& p0, f32x16& p1, float& m_reg, float& mn, float& alpha, float cb) {
  float pmax = p0[0];
#pragma unroll
  for (int r = 1; r < 16; ++r) pmax = fmaxf(pmax, p0[r]);
#pragma unroll
  for (int r = 0; r < 16; ++r) pmax = fmaxf(pmax, p1[r]);
  { auto rr = __builtin_amdgcn_permlane32_swap(__float_as_uint(pmax), __float_as_uint(pmax), false, false);
    pmax = fmaxf(__uint_as_float(rr[0]), __uint_as_float(rr[1])) + cb; }
  if (__builtin_expect(__all(pmax - m_reg <= THR), 1)) { mn = m_reg; alpha = 1.f; }
  else { mn = fmaxf(m_reg, pmax); alpha = __builtin_amdgcn_exp2f(m_reg - mn); m_reg = mn; }
  const float sh = mn - cb;
#pragma unroll
  for (int r = 0; r < 16; ++r) p0[r] = p0[r] - sh;
#pragma unroll
  for (int r = 0; r < 16; ++r) p1[r] = p1[r] - sh;
#pragma unroll
  for (int r = 0; r < 16; ++r) p0[r] = __builtin_amdgcn_exp2f(p0[r]);
}
__device__ __forceinline__ void finishSM(f32x16& p0, f32x16& p1, float alpha, float& l_reg, bf16x8& pa0, bf16x8& pa1, bf16x8& pa2, bf16x8& pa3) {
#pragma unroll
  for (int r = 0; r < 16; ++r) p1[r] = __builtin_amdgcn_exp2f(p1[r]);
  float ps = 0;
#pragma unroll
  for (int r = 0; r < 16; ++r) ps += p0[r];
#pragma unroll
  for (int r = 0; r < 16; ++r) ps += p1[r];
  { auto rr = __builtin_amdgcn_permlane32_swap(__float_as_uint(ps), __float_as_uint(ps), false, false);
    ps = __uint_as_float(rr[0]) + __uint_as_float(rr[1]); }
  l_reg = l_reg * alpha + ps;
#define PK4(P, BASE, OUT) do { unsigned a0 = cvt_pk_bf16(P[BASE + 0], P[BASE + 1]), a1 = cvt_pk_bf16(P[BASE + 2], P[BASE + 3]);   \
    unsigned b0 = cvt_pk_bf16(P[BASE + 4], P[BASE + 5]), b1 = cvt_pk_bf16(P[BASE + 6], P[BASE + 7]);                              \
    auto r0 = __builtin_amdgcn_permlane32_swap(a0, b0, false, false); auto r1 = __builtin_amdgcn_permlane32_swap(a1, b1, false, false); \
    u32x4 w = {r0[0], r1[0], r0[1], r1[1]}; OUT = *reinterpret_cast<bf16x8*>(&w); } while (0)
  PK4(p0, 0, pa0); PK4(p0, 8, pa1); PK4(p1, 0, pa2); PK4(p1, 8, pa3);
#undef PK4
}
__device__ __forceinline__ void qkt(f32x16& p0, f32x16& p1, const char* Ks, const bf16x8* qr, int r32, int cbase) {
#pragma unroll
  for (int d0 = 0; d0 < 4; ++d0) { const int cb = cbase + d0 * 32;
    bf16x8 b0 = *reinterpret_cast<const bf16x8*>(Ks + KSWZ(r32, cb));
    bf16x8 b1 = *reinterpret_cast<const bf16x8*>(Ks + KSWZ(32 + r32, cb));
    p0 = __builtin_amdgcn_mfma_f32_32x32x16_bf16(b0, qr[d0], p0, 0, 0, 0);
    p1 = __builtin_amdgcn_mfma_f32_32x32x16_bf16(b1, qr[d0], p1, 0, 0, 0); }
}
__device__ __forceinline__ int v_st(int k, int c) { const int kk = (k & ~0xC) | ((k & 4) << 1) | ((k & 8) >> 1); return ((kk >> 3) * 4 + (c >> 5)) * 512 + ((kk & 7) * 32 + (c & 31)) * 2; }
__device__ __forceinline__ int v_rd_base(int lane) { return ((lane & 3) << 3) | (((lane >> 2) & 3) << 6) | (((lane >> 4) & 1) << 5) | (((lane >> 5) & 1) << 8); }
constexpr int v_rd_off(int d0, int ks, int half) { return d0 * 512 + ks * 4096 + half * 2048; }
template <int OFF> __device__ __forceinline__ s16x4 tr_read(int vb) {
  s16x4 r; asm volatile("ds_read_b64_tr_b16 %0, %1 offset:%2" : "=&v"(r) : "v"(vb), "i"(OFF) : "memory"); return r;
}
template <int D0> __device__ __forceinline__ void pv_one(f32x16& od, int vb, bf16x8 pa0, bf16x8 pa1, bf16x8 pa2, bf16x8 pa3) {
  const s16x4 l0 = tr_read<v_rd_off(D0, 0, 0)>(vb), h0 = tr_read<v_rd_off(D0, 0, 1)>(vb), l1 = tr_read<v_rd_off(D0, 1, 0)>(vb), h1 = tr_read<v_rd_off(D0, 1, 1)>(vb);
  const s16x4 l2 = tr_read<v_rd_off(D0, 2, 0)>(vb), h2 = tr_read<v_rd_off(D0, 2, 1)>(vb), l3 = tr_read<v_rd_off(D0, 3, 0)>(vb), h3 = tr_read<v_rd_off(D0, 3, 1)>(vb);
  asm volatile("s_waitcnt lgkmcnt(0)" ::: "memory"); SBAR();
#define PK(L, H) (bf16x8){L[0], L[1], L[2], L[3], H[0], H[1], H[2], H[3]}
  od = __builtin_amdgcn_mfma_f32_32x32x16_bf16(pa0, PK(l0, h0), od, 0, 0, 0);
  od = __builtin_amdgcn_mfma_f32_32x32x16_bf16(pa1, PK(l1, h1), od, 0, 0, 0);
  od = __builtin_amdgcn_mfma_f32_32x32x16_bf16(pa2, PK(l2, h2), od, 0, 0, 0);
  od = __builtin_amdgcn_mfma_f32_32x32x16_bf16(pa3, PK(l3, h3), od, 0, 0, 0);
#undef PK
}
template <bool MEM> __device__ __forceinline__ void pv_all(f32x16* o, int vb, bf16x8 pa0, bf16x8 pa1, bf16x8 pa2, bf16x8 pa3) {
  pv_one<0>(o[0], vb, pa0, pa1, pa2, pa3); pv_one<1>(o[1], vb, pa0, pa1, pa2, pa3);
  if constexpr (!MEM) { pv_one<2>(o[2], vb, pa0, pa1, pa2, pa3); pv_one<3>(o[3], vb, pa0, pa1, pa2, pa3); }
}

template <bool MEM>
__device__ __forceinline__ void attn_unit(const bf16_t* __restrict__ Qg, int ldq, const bf16_t* __restrict__ Kg, const bf16_t* __restrict__ Vg, int ldk,
                                          bf16_t* __restrict__ Og, int q0pos, const LAS float* tab, float lam, float oscale, const float* __restrict__ gnorm, char* lds) {
  constexpr int NT = MEM ? (MEML / KVBLK) : (SEQ / KVBLK); constexpr int ND = MEM ? 2 : 4;
  const int tid = opaque_tid(), wid = __builtin_amdgcn_readfirstlane(tid >> 6), lane = tid & 63, r32 = lane & 31, hi = lane >> 5;
  const int half = wid >> 2, wq = wid & 3;
  char* V_lds = lds + L_V; char* K_lds = lds + L_K;
  float* ws = (float*)(lds + L_WS) + wid * 64; float* li_l = ws; float* al_l = ws + 32;
  float m_reg = -1e30f, l_reg = 0; f32x16 o[ND];
#pragma unroll
  for (int d = 0; d < ND; ++d) o[d] = f32x16{};
  bf16x8 qr[4];
  const bf16_t* Qw = Qg + (long)(wq * 32 + r32) * ldq + half * 64 + hi * 8;
#pragma unroll
  for (int d0 = 0; d0 < 4; ++d0) qr[d0] = *reinterpret_cast<const bf16x8*>(Qw + d0 * 16);
  const int sr = tid >> 4, sc = (tid & 15) * 8, vst0 = v_st(sr, sc), vst1 = v_st(32 + sr, sc);
  const int vb0 = (int)(uintptr_t)V_lds + v_rd_base(lane) + (MEM ? half * 1024 : 0);
  const int cbase = half * 128 + hi * 16;
  const int q0w = q0pos + wq * 32;
  float cL = 0.f, cR = 0.f;
  if constexpr (!MEM) { cL = tab[0]; cR = tab[TABN - 1]; }
  struct { bf16x8 vs0, vs1, ks0, ks1; } sr_[2];
#define SLOAD(i, k0) do { sr_[i].vs0 = *reinterpret_cast<const bf16x8*>(&Vg[(long)((k0) + sr) * ldk + sc]); sr_[i].vs1 = *reinterpret_cast<const bf16x8*>(&Vg[(long)((k0) + 32 + sr) * ldk + sc]); \
    sr_[i].ks0 = *reinterpret_cast<const bf16x8*>(&Kg[(long)((k0) + sr) * ldk + sc]); sr_[i].ks1 = *reinterpret_cast<const bf16x8*>(&Kg[(long)((k0) + 32 + sr) * ldk + sc]); } while (0)
#define SWRITE(b, i) do { *(bf16x8*)(V_lds + (b) * SHM_V + vst0) = sr_[i].vs0;          \
    *(bf16x8*)(V_lds + (b) * SHM_V + vst1) = sr_[i].vs1; const int kc = sc * 2;               \
    *(bf16x8*)(K_lds + (b) * SHM_K + KSWZ(sr, kc)) = sr_[i].ks0;                       \
    *(bf16x8*)(K_lds + (b) * SHM_K + KSWZ(32 + sr, kc)) = sr_[i].ks1; } while (0)
#define SWAIT() asm volatile("s_waitcnt vmcnt(4)" ::: "memory")
#define RESC(a) do { if (__any((a) < 1.f)) { if (hi == 0) al_l[r32] = (a); asm volatile("s_waitcnt lgkmcnt(0)" ::: "memory"); \
    _Pragma("unroll") for (int d = 0; d < ND; ++d) _Pragma("unroll") for (int r = 0; r < 16; ++r) o[d][r] *= al_l[crow(r, hi)]; } } while (0)
#define SEED(P0, P1, CB, j) do { P0 = f32x16{}; P1 = f32x16{}; CB = 0.f; if constexpr (!MEM) { const int dq = (j) * KVBLK - q0w; \
    if (dq >= -128 && dq <= 96) { const LAS float* tb = tab + (dq + 4 * hi - r32 + TABC); \
      _Pragma("unroll") for (int r = 0; r < 16; ++r) { P0[r] = tb[(r & 3) + 8 * (r >> 2)]; P1[r] = tb[32 + (r & 3) + 8 * (r >> 2)]; } } \
    else CB = dq > 0 ? cR : cL; } } while (0)
  f32x16 pA0, pA1, pB0, pB1; float mnA, mnB, alA, alB, cbA, cbB; bf16x8 pa0, pa1, pa2, pa3;
  constexpr int SE = 0, SO = 1;
  SLOAD(SE, 0); asm volatile("s_waitcnt vmcnt(0)" ::: "memory"); SWRITE(0, SE); __syncthreads();
  SEED(pA0, pA1, cbA, 0); qkt(pA0, pA1, K_lds, qr, r32, cbase); partialSM(pA0, pA1, m_reg, mnA, alA, cbA);
  SLOAD(SO, KVBLK); if (2 < NT) SLOAD(SE, 2 * KVBLK);
  SWAIT(); SWRITE(1, SO); __syncthreads();
  for (int j = 1; j + 1 < NT; j += 2) {
    SEED(pB0, pB1, cbB, j);
    SBAR(); qkt(pB0, pB1, K_lds + SHM_K, qr, r32, cbase);
    finishSM(pA0, pA1, alA, l_reg, pa0, pa1, pa2, pa3); SBAR();
    SLOAD(SO, (j + 2) * KVBLK); SBAR();
    pv_all<MEM>(o, vb0, pa0, pa1, pa2, pa3); partialSM(pB0, pB1, m_reg, mnB, alB, cbB);
    __syncthreads(); SWAIT(); SWRITE(0, SE);
    RESC(alB); __syncthreads();
    SEED(pA0, pA1, cbA, j + 1);
    SBAR(); qkt(pA0, pA1, K_lds, qr, r32, cbase);
    finishSM(pB0, pB1, alB, l_reg, pa0, pa1, pa2, pa3); SBAR();
    if (j + 3 < NT) SLOAD(SE, (j + 3) * KVBLK); SBAR();
    pv_all<MEM>(o, vb0 + SHM_V, pa0, pa1, pa2, pa3); partialSM(pA0, pA1, m_reg, mnA, alA, cbA);
    __syncthreads(); SWAIT(); SWRITE(1, SO);
    RESC(alA); __syncthreads();
  }
  SEED(pB0, pB1, cbB, NT - 1);
  SBAR(); qkt(pB0, pB1, K_lds + SHM_K, qr, r32, cbase);
  finishSM(pA0, pA1, alA, l_reg, pa0, pa1, pa2, pa3); SBAR();
  pv_all<MEM>(o, vb0, pa0, pa1, pa2, pa3); partialSM(pB0, pB1, m_reg, mnB, alB, cbB);
  __syncthreads(); RESC(alB);
  finishSM(pB0, pB1, alB, l_reg, pa0, pa1, pa2, pa3); SBAR();
  pv_all<MEM>(o, vb0 + SHM_V, pa0, pa1, pa2, pa3);
  if (hi == 0) li_l[r32] = l_reg; asm volatile("s_waitcnt lgkmcnt(0)" ::: "memory");
  float rli[16];
#pragma unroll
  for (int r = 0; r < 16; ++r) rli[r] = __builtin_amdgcn_rcpf(li_l[crow(r, hi)]);
  if constexpr (MEM) {
    bf16_t* Ow = Og + (long)(wq * 32) * DM + half * 64;
#pragma unroll
    for (int r = 0; r < 16; ++r) { const int orow = crow(r, hi);
#pragma unroll
      for (int d0 = 0; d0 < 2; ++d0) Ow[(long)orow * DM + d0 * 32 + r32] = (bf16_t)(cvt_pk_bf16(o[d0][r] * rli[r], 0.f) & 0xffffu); }
  } else {
    LAS float* ex = (LAS float*)((LAS char*)lds + L_EX) + wq * 4096 + lane;
    if (half == 1) {
#pragma unroll
      for (int d0 = 0; d0 < 4; ++d0)
#pragma unroll
        for (int r = 0; r < 16; ++r) ex[(d0 * 16 + r) * 64] = o[d0][r] * rli[r];
    }
    __syncthreads();
    if (half == 0) {
      float ss[16];
#pragma unroll
      for (int r = 0; r < 16; ++r) { float s = 0.f;
#pragma unroll
        for (int d0 = 0; d0 < 4; ++d0) { const float x = o[d0][r] * rli[r] - lam * ex[(d0 * 16 + r) * 64]; o[d0][r] = x; s += x * x; }
        ss[r] = s; }
#pragma unroll
      for (int off = 1; off < 32; off <<= 1)
#pragma unroll
        for (int r = 0; r < 16; ++r) ss[r] += __shfl_xor(ss[r], off);
      float gv[4];
#pragma unroll
      for (int d0 = 0; d0 < 4; ++d0) gv[d0] = gnorm[d0 * 32 + r32] * oscale;
      bf16_t* Ow = Og + (long)(wq * 32) * DM;
#pragma unroll
      for (int r = 0; r < 16; ++r) { const int orow = crow(r, hi); const float rs = __builtin_amdgcn_rsqf(ss[r] * (1.f / 128.f) + LN_EPS);
#pragma unroll
        for (int d0 = 0; d0 < 4; ++d0) Ow[(long)orow * DM + d0 * 32 + r32] = (bf16_t)(cvt_pk_bf16(o[d0][r] * rs * gv[d0], 0.f) & 0xffffu); }
    }
  }
#undef SLOAD
#undef SWRITE
#undef SWAIT
#undef RESC
#undef SEED
}
#undef SBAR
}

struct Args {
    const float* x; const float* mem; const float* emb_g; const float* emb_b; const float* rel_bias;
    const float* w_in; const float* b_in; const float* conv_w; const float* conv_b; const float* conv_ln_g; const float* conv_ln_b;
    const float* lq1; const float* lk1; const float* lq2; const float* lk2; const float* diff_g; const float* w_mkv;
    const float* w_out; const float* b_out; const float* ln1_g; const float* ln1_b; const float* w_up; const float* w_down; const float* ln2_g; const float* ln2_b;
    float* out; unsigned char* ws;
    float lam_init[4];
};

__device__ __forceinline__ void transpose_item(const float* __restrict__ W, int K, int N, bf16_t* __restrict__ WT, int row_off, LAS float* scr, int item, int lane) {
    const int nblk = N / 32, kb = item / nblk, nb = item % nblk, k0 = 64 * kb, n0 = 32 * nb;
#pragma unroll 8
    for (int i = 0; i < 32; ++i) { const int kk = 2 * i + (lane >> 5); scr[kk * 33 + (lane & 31)] = W[(size_t)(k0 + kk) * N + n0 + (lane & 31)]; }
    asm volatile("s_waitcnt lgkmcnt(0)" ::: "memory");
    const int c = lane & 7;
#pragma unroll
    for (int j = 0; j < 4; ++j) { const int n = (lane >> 3) + 8 * j; const LAS float* s = scr + (8 * c) * 33 + n;
        u32x4 o; o.x = cvt_pk_bf16(s[0 * 33], s[1 * 33]); o.y = cvt_pk_bf16(s[2 * 33], s[3 * 33]); o.z = cvt_pk_bf16(s[4 * 33], s[5 * 33]); o.w = cvt_pk_bf16(s[6 * 33], s[7 * 33]);
        *(u32x4*)(WT + (size_t)(row_off + n0 + n) * K + k0 + 8 * c) = o; }
    asm volatile("s_waitcnt lgkmcnt(0)" ::: "memory");
}
__device__ __forceinline__ void ln_row(const float* xrow, float* of, bf16_t* ob, const float* __restrict__ g, const float* __restrict__ b, int lane) {
    const f32x4* xr = (const f32x4*)xrow + lane;
    f32x4 v[4]; float s = 0.f;
#pragma unroll
    for (int j = 0; j < 4; ++j) { v[j] = xr[64 * j]; s += (v[j].x + v[j].y) + (v[j].z + v[j].w); }
    const float mean = wave_sum(s) * (1.f / DM); float s2 = 0.f;
#pragma unroll
    for (int j = 0; j < 4; ++j) { v[j] = v[j] - mean; s2 += (v[j].x * v[j].x + v[j].y * v[j].y) + (v[j].z * v[j].z + v[j].w * v[j].w); }
    const float rstd = __builtin_amdgcn_rsqf(wave_sum(s2) * (1.f / DM) + LN_EPS);
#pragma unroll
    for (int j = 0; j < 4; ++j) { const f32x4 gg = ((const f32x4*)g)[lane + 64 * j], bb = ((const f32x4*)b)[lane + 64 * j];
        const f32x4 y = v[j] * rstd * gg + bb;
        ((f32x4*)of)[lane + 64 * j] = y;
        u32x2 w; w.x = cvt_pk_bf16(y.x, y.y); w.y = cvt_pk_bf16(y.z, y.w); ((u32x2*)ob)[lane + 64 * j] = w; }
}
__device__ __forceinline__ void ln_phase(const float* src, float* dstf, bf16_t* dstb, const float* g, const float* b, int gw, int ngw, int lane_) {
    const int lane = opaque_tid() & 63; (void)lane_;
    for (int m = gw; m < MTOK; m += ngw) ln_row(src + (size_t)m * DM, dstf + (size_t)m * DM, dstb + (size_t)m * DM, g, b, lane);
}
__device__ __forceinline__ int t5_bucket(int rel) {
    const int n = rel < 0 ? -rel : rel; int b = rel > 0 ? 16 : 0;
    if (n < 8) return b + n;
    int lg = 2 + (31 - __clz(n * n)); if (lg > 15) lg = 15;
    return b + lg;
}

__device__ __forceinline__ void conv_unit(const bf16_t* __restrict__ proj, bf16_t* __restrict__ mixed, const float* __restrict__ cw, const float* __restrict__ cb,
                                          const float* __restrict__ lg, const float* __restrict__ lb, int unit, LAS float* U) {
    const int tid = opaque_tid(), lane = tid & 63, wid = tid >> 6;
    const int b = unit >> 7, t0 = (unit & 127) * 32;
    LAS float* Y = U + 62 * 256;
    for (int task = tid; task < 62 * 32; task += 512) {
        const int rr = task >> 5, ch = (task & 31) * 8; const int t = t0 - 15 + rr;
        f32x4 u0 = {0.f, 0.f, 0.f, 0.f}, u1 = {0.f, 0.f, 0.f, 0.f};
        if (t >= 0 && t < SEQ) {
            const bf16_t* p = proj + (size_t)(b * SEQ + t) * INW + ch;
            const bf16x8 av = *(const bf16x8*)p, gv = *(const bf16x8*)(p + CONVC);
            float uu[8];
#pragma unroll
            for (int i = 0; i < 8; ++i) { const float a = bf2f((unsigned short)av[i]), g = bf2f((unsigned short)gv[i]); uu[i] = a * __builtin_amdgcn_rcpf(1.f + __expf(-g)); }
            u0 = (f32x4){uu[0], uu[1], uu[2], uu[3]}; u1 = (f32x4){uu[4], uu[5], uu[6], uu[7]};
        }
        *(LAS f32x4*)(U + rr * 256 + ch) = u0; *(LAS f32x4*)(U + rr * 256 + ch + 4) = u1;
    }
    __syncthreads();
    const int c = tid & 255, th = tid >> 8;
    float w[CONVW];
#pragma unroll
    for (int j = 0; j < CONVW; ++j) w[j] = cw[j * CONVC + c];
    const float bias = cb[c];
    const LAS float* Ub = U + (th * 16) * 256 + c;
#pragma unroll 1
    for (int t = 0; t < 16; ++t) {
        float s0 = bias, s1 = 0.f;
#pragma unroll
        for (int j = 0; j < CONVW; j += 2) { s0 += w[j] * Ub[(t + j) * 256]; if (j + 1 < CONVW) s1 += w[j + 1] * Ub[(t + j + 1) * 256]; }
        Y[(th * 16 + t) * 256 + c] = s0 + s1;
    }
    __syncthreads();
    const f32x4 gg = ((const f32x4*)lg)[lane], bb = ((const f32x4*)lb)[lane];
#pragma unroll
    for (int k = 0; k < 4; ++k) { const int tok = wid * 4 + k;
        f32x4 y = *(const LAS f32x4*)(Y + tok * 256 + lane * 4);
        const float mean = wave_sum((y.x + y.y) + (y.z + y.w)) * (1.f / 256.f); y = y - mean;
        const float rstd = __builtin_amdgcn_rsqf(wave_sum((y.x * y.x + y.y * y.y) + (y.z * y.z + y.w * y.w)) * (1.f / 256.f) + LN_EPS);
        y = y * rstd * gg + bb;
        f32x4 z; z.x = y.x * __builtin_amdgcn_rcpf(1.f + __expf(-y.x)); z.y = y.y * __builtin_amdgcn_rcpf(1.f + __expf(-y.y));
        z.z = y.z * __builtin_amdgcn_rcpf(1.f + __expf(-y.z)); z.w = y.w * __builtin_amdgcn_rcpf(1.f + __expf(-y.w));
        u32x2 o; o.x = cvt_pk_bf16(z.x, z.y); o.y = cvt_pk_bf16(z.z, z.w);
        *(u32x2*)(mixed + (size_t)(b * SEQ + t0 + tok) * DM + lane * 4) = o; }
    __syncthreads();
}

__global__ void __launch_bounds__(NWAVES * 64, 2) mk_fwd(Args a) {
    extern __shared__ __attribute__((aligned(16))) unsigned char lds[];
    cg::grid_group grid = cg::this_grid();
    LAS unsigned char* ldsL = (LAS unsigned char*)lds;
    const int tid = threadIdx.x, lane = tid & 63, wave = __builtin_amdgcn_readfirstlane(tid >> 6);
    const int G = gridDim.x, bx = blockIdx.x;
    const int vcu = (G % 8 == 0) ? (bx % 8) * (G / 8) + bx / 8 : bx;
    const int gw = bx * NWAVES + wave, ngw = G * NWAVES;
    unsigned char* ws = a.ws;
    bf16_t* WIN = (bf16_t*)(ws + WS_WIN); bf16_t* WOUT = (bf16_t*)(ws + WS_WOUT); bf16_t* WUP = (bf16_t*)(ws + WS_WUP); bf16_t* WDN = (bf16_t*)(ws + WS_WDN);
    bf16_t* WMKV = (bf16_t*)(ws + WS_WMKV); bf16_t* MEMB = (bf16_t*)(ws + WS_MEMB); bf16_t* MEMKV = (bf16_t*)(ws + WS_MEMKV);
    bf16_t* XB = (bf16_t*)(ws + WS_XB); bf16_t* HB = (bf16_t*)(ws + WS_H); bf16_t* PROJ = (bf16_t*)(ws + WS_PROJ); bf16_t* MIXED = (bf16_t*)(ws + WS_MIXED);
    float* X = a.out;

    {
        LAS float* scr = (LAS float*)(ldsL + wave * 16384);
        constexpr int I_IN = (DM / 64) * (INW / 32), I_OUT = (DM / 64) * (DM / 32), I_UP = (DM / 64) * (FF / 32), I_DN = (FF / 64) * (DM / 32), I_MKV = (DM / 64) * (512 / 32);
        constexpr int I_LAYER = I_IN + I_OUT + I_UP + I_DN + I_MKV;
        for (int it = gw; it < DEPTH * I_LAYER; it += ngw) {
            const int l = it / I_LAYER; int r = it % I_LAYER;
            if (r < I_IN) { transpose_item(a.w_in + (size_t)l * DM * INW, DM, INW, WIN + (size_t)l * INW * DM, 0, scr, r, lane); continue; } r -= I_IN;
            if (r < I_OUT) { transpose_item(a.w_out + (size_t)l * DM * DM, DM, DM, WOUT + (size_t)l * DM * DM, 0, scr, r, lane); continue; } r -= I_OUT;
            if (r < I_UP) { transpose_item(a.w_up + (size_t)l * DM * FF, DM, FF, WUP + (size_t)l * FF * DM, 0, scr, r, lane); continue; } r -= I_UP;
            if (r < I_DN) { transpose_item(a.w_down + (size_t)l * FF * DM, FF, DM, WDN + (size_t)l * DM * FF, 0, scr, r, lane); continue; } r -= I_DN;
            transpose_item(a.w_mkv + (size_t)l * DM * 512, DM, 512, WMKV, l * 512, scr, r, lane);
        }
        for (size_t i = (size_t)bx * 512 + tid; i < (size_t)MMEM * DM / 8; i += (size_t)G * 512) {
            const f32x4 v0 = ((const f32x4*)a.mem)[2 * i], v1 = ((const f32x4*)a.mem)[2 * i + 1];
            u32x4 o; o.x = cvt_pk_bf16(v0.x, v0.y); o.y = cvt_pk_bf16(v0.z, v0.w); o.z = cvt_pk_bf16(v1.x, v1.y); o.w = cvt_pk_bf16(v1.z, v1.w);
            ((u32x4*)MEMB)[i] = o;
        }
        ln_phase(a.x, X, XB, a.emb_g, a.emb_b, gw, ngw, lane);
    }
    grid.sync();
    {
        pg8::Gemm g{MEMB, WMKV, MMEM, DEPTH * 512, DM}; pg8::StaticOrder S; S.init(MMEM, DEPTH * 512, G, bx);
        pg8::EpiStore<0> E{MEMKV, DEPTH * 512, nullptr};
#ifndef SKIP_GMKV
        pg8::gemm_phase<pg8::EpiStore<0>, pg8::StaticOrder>(ldsL, g, S, E);
#endif
    }

    for (int l = 0; l < DEPTH; ++l) {
        {
            pg8::Gemm g{XB, WIN + (size_t)l * INW * DM, MTOK, INW, DM}; pg8::StaticOrder S; S.init(MTOK, INW, G, bx);
            pg8::EpiStore<1> E{PROJ, INW, a.b_in + l * INW};
#ifndef SKIP_GPROJ
            pg8::gemm_phase<pg8::EpiStore<1>, pg8::StaticOrder>(ldsL, g, S, E);
#endif
        }
        grid.sync();
#if defined(STOP_AT) && STOP_AT == 1
        return;
#endif
        {
            LAS float* tabs = (LAS float*)(ldsL + att::L_TAB);
            for (int i = tid; i < 4 * att::TABN; i += 512) { const int h = i / att::TABN, rel = i % att::TABN - att::TABC; tabs[i] = a.rel_bias[t5_bucket(rel) * 4 + h] * LOG2E; }
            float lam;
            { const float d1 = wave_sum(a.lq1[l * 64 + lane] * a.lk1[l * 64 + lane]), d2 = wave_sum(a.lq2[l * 64 + lane] * a.lk2[l * 64 + lane]);
              lam = expf(d1) - expf(d2) + a.lam_init[l]; }
            const float oscale = 1.f - a.lam_init[l];
            __syncthreads();
#ifndef SKIP_DIFF
            for (int id = vcu; id < BATCH * 4 * 32; id += G) {
                const int bh = id >> 5, qb = id & 31, b = bh >> 2, h = bh & 3;
                const size_t row0 = (size_t)b * SEQ + qb * 128;
                att::attn_unit<false>(PROJ + row0 * INW + 512 + h * 128, INW, PROJ + (size_t)b * SEQ * INW + 1024 + h * 128, PROJ + (size_t)b * SEQ * INW + 1536 + h * 128, INW,
                                      MIXED + row0 * DM + 256 + h * 128, qb * 128, tabs + h * att::TABN, lam, oscale, a.diff_g + l * 128, (char*)lds);
            }
#endif
            __syncthreads();
#ifndef SKIP_MEMATT
            for (int id = vcu; id < BATCH * 2 * 32; id += G) {
                const int bp = id >> 5, qb = id & 31, b = bp >> 1, hp = bp & 1;
                const size_t row0 = (size_t)b * SEQ + qb * 128;
                att::attn_unit<true>(PROJ + row0 * INW + 2048 + hp * 128, INW, MEMKV + (size_t)b * MEML * 2048 + l * 512 + hp * 128, MEMKV + (size_t)b * MEML * 2048 + l * 512 + 256 + hp * 128, 2048,
                                     MIXED + row0 * DM + 768 + hp * 128, 0, tabs, 0.f, 0.f, nullptr, (char*)lds);
            }
#endif
            __syncthreads();
#ifndef SKIP_CONV
            for (int id = bx; id < MTOK / 32; id += G)
                conv_unit(PROJ, MIXED, a.conv_w + l * CONVW * CONVC, a.conv_b + l * CONVC, a.conv_ln_g + l * CONVC, a.conv_ln_b + l * CONVC, id, (LAS float*)ldsL);
#endif
        }
        grid.sync();
#if defined(STOP_AT) && STOP_AT == 2
        return;
#endif
        {
            pg8::Gemm g{MIXED, WOUT + (size_t)l * DM * DM, MTOK, DM, DM}; pg8::StaticOrder S; S.init(MTOK, DM, G, bx);
            pg8::EpiResid E{X, a.b_out + l * DM};
#ifndef SKIP_GOUT
            pg8::gemm_phase<pg8::EpiResid, pg8::StaticOrder>(ldsL, g, S, E);
#endif
        }
        grid.sync();
#ifndef SKIP_LN
        ln_phase(X, X, XB, a.ln1_g + l * DM, a.ln1_b + l * DM, gw, ngw, lane);
#endif
        grid.sync();
#if defined(STOP_AT) && STOP_AT == 3
        return;
#endif
        {
            pg8::Gemm g{XB, WUP + (size_t)l * FF * DM, MTOK, FF, DM}; pg8::StaticOrder S; S.init(MTOK, FF, G, bx);
            pg8::EpiStore<2> E{HB, FF, nullptr};
#ifndef SKIP_GUP
            pg8::gemm_phase<pg8::EpiStore<2>, pg8::StaticOrder>(ldsL, g, S, E);
#endif
        }
        grid.sync();
        {
            pg8::Gemm g{HB, WDN + (size_t)l * DM * FF, MTOK, DM, FF}; pg8::StaticOrder S; S.init(MTOK, DM, G, bx);
            pg8::EpiResid E{X, nullptr};
#ifndef SKIP_GDOWN
            pg8::gemm_phase<pg8::EpiResid, pg8::StaticOrder>(ldsL, g, S, E);
#endif
        }
        grid.sync();
#ifndef SKIP_LN
        ln_phase(X, X, XB, a.ln2_g + l * DM, a.ln2_b + l * DM, gw, ngw, lane);
#endif
        grid.sync();
    }
}

extern "C" void kernel_launch(void* const* d_in, const int* in_sizes, int n_in, void* d_out, int out_size, void* d_ws, size_t ws_size, hipStream_t stream) {
    static int grid = 0;
    if (grid == 0) {
        if (n_in != 25 || in_sizes[0] != MTOK * DM || out_size != MTOK * DM || ws_size < WS_END) {
            fprintf(stderr, "kernel_launch: unexpected shapes: n_in %d in0 %d out %d ws %zu (need >= %zu)\n", n_in, n_in > 0 ? in_sizes[0] : -1, out_size, ws_size, (size_t)WS_END); grid = -1; return; }
        int dev = 0, cus = 0, per_cu = 0;
        if (hipGetDevice(&dev) != hipSuccess || hipDeviceGetAttribute(&cus, hipDeviceAttributeMultiprocessorCount, dev) != hipSuccess) { fprintf(stderr, "kernel_launch: device query failed\n"); grid = -1; return; }
        if (hipFuncSetAttribute((const void*)mk_fwd, hipFuncAttributeMaxDynamicSharedMemorySize, LDS_BYTES) != hipSuccess) { fprintf(stderr, "kernel_launch: hipFuncSetAttribute failed\n"); grid = -1; return; }
        if (hipOccupancyMaxActiveBlocksPerMultiprocessor(&per_cu, (const void*)mk_fwd, NWAVES * 64, LDS_BYTES) != hipSuccess || per_cu < 1) { fprintf(stderr, "kernel_launch: occupancy query says %d\n", per_cu); per_cu = 1; }
        (void)hipGetLastError();
        grid = cus * per_cu;
    }
    if (grid < 0) return;
    Args a{};
    const float** f = (const float**)&a;
    for (int i = 0; i < 25; ++i) f[i] = (const float*)d_in[i];
    a.out = (float*)d_out; a.ws = (unsigned char*)d_ws;
    for (int l = 0; l < 4; ++l) a.lam_init[l] = (float)(0.8 - 0.6 * std::exp(-0.3 * (double)l));
    void* args[] = {&a};
    hipError_t e = hipLaunchCooperativeKernel((const void*)mk_fwd, dim3(grid), dim3(NWAVES * 64), args, LDS_BYTES, stream);
    if (e != hipSuccess) { fprintf(stderr, "kernel_launch: cooperative launch failed: %s (grid %d)\n", hipGetErrorString(e), grid); (void)hipGetLastError(); (void)hipMemsetAsync(d_out, 0, (size_t)out_size * 4, stream); }
}
```

```cpp
#define ATT2
#include <hip/hip_runtime.h>
#include <hip/hip_cooperative_groups.h>
#include <cstdio>
#include <cstdint>
#include <cmath>
namespace cg = cooperative_groups;

#define LAS __attribute__((address_space(3)))
typedef unsigned short bf16_t;
typedef short bf16x8 __attribute__((ext_vector_type(8)));
typedef short s16x4 __attribute__((ext_vector_type(4)));
typedef float f32x4 __attribute__((ext_vector_type(4)));
typedef float f32x2 __attribute__((ext_vector_type(2)));
typedef float f32x16 __attribute__((ext_vector_type(16)));
typedef unsigned u32x4 __attribute__((ext_vector_type(4)));
typedef unsigned u32x2 __attribute__((ext_vector_type(2)));

constexpr int BATCH = 16, SEQ = 4096, DM = 1024, DEPTH = 4, MEML = 256, INW = 2304, FF = 4096;
constexpr int MTOK = BATCH * SEQ;
constexpr int MMEM = BATCH * MEML;
constexpr int CONVC = 256, CONVW = 31;
constexpr float ALPHA = 1.6817928305074290f;
constexpr float LN_EPS = 1e-5f;
constexpr float LOG2E = 1.4426950408889634f;
constexpr float QSCALE = 0.125f * LOG2E;
constexpr int NWAVES = 8;

constexpr size_t MiB = 1u << 20;
constexpr size_t WS_WIN = 0;
constexpr size_t WS_WOUT = 18 * MiB;
constexpr size_t WS_WUP = 26 * MiB;
constexpr size_t WS_WDN = 58 * MiB;
constexpr size_t WS_WMKV = 90 * MiB;
constexpr size_t WS_MEMB = 94 * MiB;
constexpr size_t WS_MEMKV = 102 * MiB;
constexpr size_t WS_XB = 120 * MiB;
constexpr size_t WS_H = 248 * MiB;
constexpr size_t WS_PROJ = 248 * MiB;
constexpr size_t WS_MIXED = 536 * MiB;
constexpr size_t WS_STA = 760 * MiB;
constexpr size_t WS_STB = 762 * MiB;
constexpr size_t WS_PUV = 764 * MiB;
constexpr size_t WS_UV = 768 * MiB;
constexpr size_t WS_CTL = 769 * MiB;
constexpr size_t CTL_BYTES = 16384;
constexpr size_t WS_END = 770 * MiB;

constexpr int LDS_MISC = 155648;
constexpr int LDS_BYTES = 155648 + 64;

__device__ __forceinline__ unsigned cvt_pk_bf16(float lo, float hi) { unsigned r; asm volatile("v_cvt_pk_bf16_f32 %0, %1, %2" : "=v"(r) : "v"(lo), "v"(hi)); return r; }
__device__ __forceinline__ float bf2f(unsigned short b) { return __uint_as_float(((unsigned)b) << 16); }
__device__ __forceinline__ int opaque_tid() { int t = threadIdx.x; asm volatile("" : "+v"(t)); return t; }
__device__ __forceinline__ float shfl_xor_f(float v, int o) { const int ln = opaque_tid() & 63; return __int_as_float(__builtin_amdgcn_ds_bpermute((ln ^ o) << 2, __float_as_int(v))); }
__device__ __forceinline__ float wave_sum(float v) {
#pragma unroll
    for (int o = 1; o < 64; o <<= 1) v += shfl_xor_f(v, o);
    return v;
}

namespace pg8 {
constexpr int BM = 256, BK = 64, HALF = 128, HTB = HALF * BK * 2, STAGE_BYTES = 8 * HTB, NXCD = 8, WGM = 8;
__host__ __device__ __forceinline__ int lds_byte(int r, int c) { const int st = (r >> 4) * 2 + (c >> 5), rr = r & 15, cc = c & 31, ob = rr * 64 + cc * 2; return st * 1024 + (ob ^ (((ob >> 9) & 1) << 5)); }
__host__ __device__ __forceinline__ void stage_rc(int b, int& R, int& C) { const int st = b / 1024, sb = b % 1024, swz = sb ^ (((sb >> 9) & 1) << 5); R = (st >> 1) * 16 + swz / 64; C = (st & 1) * 32 + (swz % 64) / 2; }
__host__ __device__ __forceinline__ int perm32(int rho) { const int n = rho >> 4, i = rho & 15; return 8 * (i >> 2) + 4 * n + (i & 3); }

struct Unit { int pm, pn; };
struct Gemm { const bf16_t* A; const bf16_t* Bt; int M, N, K; };

struct StaticOrder {
    int nM, nN, nwg, G, c;
    __host__ __device__ void init(int M, int N, int G_, int c_) { nM = M / BM; nN = N / BM; nwg = nM * nN; G = G_; c = c_; }
    __host__ __device__ bool next(int i, Unit& u) const {
        const long L = (long)i * G + c; if (L >= nwg) return false;
        int wgid = (int)L; { const int q = nwg / NXCD, r = nwg % NXCD, xcd = wgid % NXCD, off = wgid / NXCD; wgid = (xcd < r ? xcd * (q + 1) : r * (q + 1) + (xcd - r) * q) + off; }
        const int nig = WGM * nN, gid = wgid / nig, fm = gid * WGM, gsz = (nM - fm) < WGM ? (nM - fm) : WGM;
        u.pm = fm + ((wgid % nig) % gsz); u.pn = (wgid % nig) / gsz; return true;
    }
};

__device__ __forceinline__ void row_mean_rstd(const float* st, int row, float& mu, float& rs) {
    const f32x4 s0 = *(const f32x4*)(st + (size_t)row * 8), s1 = *(const f32x4*)(st + (size_t)row * 8 + 4);
    const float S = (s0.x + s0.z) + (s1.x + s1.z), Q = (s0.y + s0.w) + (s1.y + s1.w);
    mu = S * (1.f / DM); rs = __builtin_amdgcn_rsqf(fmaxf(Q * (1.f / DM) - mu * mu, 0.f) + LN_EPS);
}
template <int MODE> struct EpiStore {
    static constexpr bool PERM = true;
    bf16_t* O; int ldc; const float* st; const float* U; const float* V;
    __device__ __forceinline__ void operator()(f32x4 (&acc)[2][2][4][2], const Unit& u, int wr, int wc, int fr, int fq, LAS unsigned char* lds, int tid) const {
        const int row0 = u.pm * BM + wr * 64 + fr; const int col0 = u.pn * BM + wc * 32 + 8 * fq;
        float sc = 1.f; if (MODE == 1) { if (u.pn == 2 || u.pn == 3 || u.pn == 8) sc = QSCALE; }
        f32x4 uu[2][2], vv[2][2];
#pragma unroll
        for (int bj = 0; bj < 2; ++bj)
#pragma unroll
            for (int n = 0; n < 2; ++n) { uu[bj][n] = (MODE != 0) ? *(const f32x4*)(U + col0 + bj * HALF + 4 * n) : (f32x4){0.f, 0.f, 0.f, 0.f}; vv[bj][n] = (MODE != 0) ? *(const f32x4*)(V + col0 + bj * HALF + 4 * n) : (f32x4){0.f, 0.f, 0.f, 0.f}; }
#pragma unroll
        for (int ai = 0; ai < 2; ++ai)
#pragma unroll
            for (int m = 0; m < 4; ++m) { const int row = row0 + ai * HALF + m * 16; bf16_t* rowp = O + (size_t)row * ldc + col0;
                float mu = 0.f, rs = 1.f; if (MODE != 0) row_mean_rstd(st, row, mu, rs);
#pragma unroll
                for (int bj = 0; bj < 2; ++bj) { f32x4 v0 = acc[ai][bj][m][0], v1 = acc[ai][bj][m][1];
                    if (MODE != 0) { v0 = (v0 - uu[bj][0] * mu) * rs + vv[bj][0]; v1 = (v1 - uu[bj][1] * mu) * rs + vv[bj][1]; }
                    if (MODE == 2) { v0 = __builtin_elementwise_max(v0, (f32x4){0.f, 0.f, 0.f, 0.f}); v1 = __builtin_elementwise_max(v1, (f32x4){0.f, 0.f, 0.f, 0.f}); v0 = v0 * v0; v1 = v1 * v1; }
                    if (MODE == 1) { v0 = v0 * sc; v1 = v1 * sc; }
                    u32x4 w; w.x = cvt_pk_bf16(v0[0], v0[1]); w.y = cvt_pk_bf16(v0[2], v0[3]); w.z = cvt_pk_bf16(v1[0], v1[1]); w.w = cvt_pk_bf16(v1[2], v1[3]);
                    if (MODE == 2) __builtin_nontemporal_store(w, (u32x4*)(rowp + bj * HALF)); else *(u32x4*)(rowp + bj * HALF) = w; } }
    }
};
struct EpiResid {
    static constexpr bool PERM = true;
    bf16_t* XB; const float* sp; const float* gp; const float* bp; float* sn; const float* bias;
    __device__ __forceinline__ void operator()(f32x4 (&acc)[2][2][4][2], const Unit& u, int wr, int wc, int fr, int fq, LAS unsigned char* lds, int tid) const {
        const int col0 = u.pn * BM + wc * 32 + 8 * fq;
        LAS f32x2* P = (LAS f32x2*)(lds + STAGE_BYTES);
        f32x4 gg[2][2], bb[2][2];
#pragma unroll
        for (int bj = 0; bj < 2; ++bj)
#pragma unroll
            for (int n = 0; n < 2; ++n) { gg[bj][n] = *(const f32x4*)(gp + col0 + bj * HALF + n * 4) * ALPHA;
                bb[bj][n] = *(const f32x4*)(bp + col0 + bj * HALF + n * 4) * ALPHA; if (bias) bb[bj][n] = bb[bj][n] + *(const f32x4*)(bias + col0 + bj * HALF + n * 4); }
#pragma unroll
        for (int ai = 0; ai < 2; ++ai)
#pragma unroll
            for (int m = 0; m < 4; ++m) { const int rloc = ai * HALF + wr * 64 + m * 16 + fr, row = u.pm * BM + rloc;
                float mu, rs; row_mean_rstd(sp, row, mu, rs);
                bf16_t* rb = XB + (size_t)row * DM + col0; float s = 0.f, q = 0.f;
#pragma unroll
                for (int bj = 0; bj < 2; ++bj) { const u32x4 xw = *(const u32x4*)(rb + bj * HALF);
                    const f32x4 x0 = {__uint_as_float(xw.x << 16), __uint_as_float(xw.x & 0xffff0000u), __uint_as_float(xw.y << 16), __uint_as_float(xw.y & 0xffff0000u)};
                    const f32x4 x1 = {__uint_as_float(xw.z << 16), __uint_as_float(xw.z & 0xffff0000u), __uint_as_float(xw.w << 16), __uint_as_float(xw.w & 0xffff0000u)};
                    const f32x4 t0 = (x0 - mu) * rs * gg[bj][0] + bb[bj][0] + acc[ai][bj][m][0];
                    const f32x4 t1 = (x1 - mu) * rs * gg[bj][1] + bb[bj][1] + acc[ai][bj][m][1];
                    u32x4 w; w.x = cvt_pk_bf16(t0.x, t0.y); w.y = cvt_pk_bf16(t0.z, t0.w); w.z = cvt_pk_bf16(t1.x, t1.y); w.w = cvt_pk_bf16(t1.z, t1.w);
                    __builtin_nontemporal_store(w, (u32x4*)(rb + bj * HALF));
                    s += ((t0.x + t0.y) + (t0.z + t0.w)) + ((t1.x + t1.y) + (t1.z + t1.w));
                    q += ((t0.x * t0.x + t0.y * t0.y) + (t0.z * t0.z + t0.w * t0.w)) + ((t1.x * t1.x + t1.y * t1.y) + (t1.z * t1.z + t1.w * t1.w)); }
                s += shfl_xor_f(s, 16); q += shfl_xor_f(q, 16); s += shfl_xor_f(s, 32); q += shfl_xor_f(q, 32);
                if (fq == 0) P[rloc * 4 + wc] = (f32x2){s, q};
                if (m & 1) asm volatile("" ::: "memory"); }
        asm volatile("s_waitcnt lgkmcnt(0)" ::: "memory"); __builtin_amdgcn_s_barrier(); asm volatile("" ::: "memory");
        if (tid < 256) { const f32x2 p0 = P[tid * 4 + 0], p1 = P[tid * 4 + 1], p2 = P[tid * 4 + 2], p3 = P[tid * 4 + 3];
            *(f32x2*)(sn + (size_t)(u.pm * BM + tid) * 8 + u.pn * 2) = (f32x2){(p0.x + p1.x) + (p2.x + p3.x), (p0.y + p1.y) + (p2.y + p3.y)}; }
    }
};

template <class Epi, class Sched>
__device__ __forceinline__ void gemm_phase(LAS unsigned char* lds, const Gemm g, const Sched& S, const Epi& E) {
    const int tid = opaque_tid(), wid = __builtin_amdgcn_readfirstlane(tid >> 6), lane = tid & 63, wr = wid >> 2, wc = wid & 3, fr = lane & 15, fq = lane >> 4;
    const int K = g.K, nt = K / BK;
    unsigned voffA[2], voffB[2];
#pragma unroll
    for (int i = 0; i < 2; ++i) { int R, C; stage_rc(tid * 16 + i * 8192, R, C); const int Rb = Epi::PERM ? ((R & ~31) + perm32(R & 31)) : R;
        voffA[i] = (unsigned)(R * K + C) * 2u; voffB[i] = (unsigned)(Rb * K + C) * 2u; }
    const size_t kstep = (size_t)(BK * 2);
    const size_t hstep = (size_t)HALF * K * 2;
    const size_t tstep = 2 * hstep;
    const unsigned ldsw = (unsigned)wid * 1024u;
    const int aoff = lds_byte(wr * 64 + fr, fq * 8), boff = lds_byte(wc * 32 + fr, fq * 8);
#define PG8_SA(b, h) (((b) * 2 + (h)) * HTB)
#define PG8_SB(b, h) ((4 + (b) * 2 + (h)) * HTB)
#define PG8_STAGE(bufoff, gbase, voff) do { _Pragma("unroll") for (int _i = 0; _i < 2; ++_i) \
        __builtin_amdgcn_global_load_lds((const unsigned*)((const char*)(gbase) + (voff)[_i]), (LAS unsigned*)(lds + (bufoff) + ldsw + _i * 8192), 16, 0, 0); } while (0)
#define PG8_LDA(dst, b, h) do { _Pragma("unroll") for (int m = 0; m < 4; ++m) _Pragma("unroll") for (int k = 0; k < 2; ++k) dst[m][k] = *(const LAS bf16x8*)(lds + PG8_SA(b, h) + aoff + m * 2048 + k * 1024); } while (0)
#define PG8_LDB(dst, b, h) do { _Pragma("unroll") for (int n = 0; n < 2; ++n) _Pragma("unroll") for (int k = 0; k < 2; ++k) dst[n][k] = *(const LAS bf16x8*)(lds + PG8_SB(b, h) + boff + n * 2048 + k * 1024); } while (0)
#define PG8_MMA(ai, bj, At, Bt) do { __builtin_amdgcn_s_setprio(1); _Pragma("unroll") for (int m = 0; m < 4; ++m) _Pragma("unroll") for (int n = 0; n < 2; ++n) _Pragma("unroll") for (int k = 0; k < 2; ++k) \
        acc[ai][bj][m][n] = __builtin_amdgcn_mfma_f32_16x16x32_bf16(Bt[n][k], At[m][k], acc[ai][bj][m][n], 0, 0, 0); __builtin_amdgcn_s_setprio(0); } while (0)
#define PG8_WAIT_V(n) asm volatile("s_waitcnt vmcnt(" #n ")" ::: "memory")
#define PG8_WAIT_L(n) asm volatile("s_waitcnt lgkmcnt(" #n ")" ::: "memory")
#define PG8_BAR __builtin_amdgcn_s_barrier()
#define PG8_SCHED __builtin_amdgcn_sched_barrier(0)
    Unit cur, nxt; int ui = 0;
    if (!S.next(0, cur)) return;
    f32x4 acc[2][2][4][2];
#pragma unroll
    for (int a = 0; a < 2; ++a)
#pragma unroll
        for (int b = 0; b < 2; ++b)
#pragma unroll
            for (int m = 0; m < 4; ++m)
#pragma unroll
                for (int n = 0; n < 2; ++n) acc[a][b][m][n] = (f32x4){0.f, 0.f, 0.f, 0.f};
    bf16x8 At[4][2], B0[2][2], B1[2][2];
    const char* cA = (const char*)g.A + (size_t)cur.pm * tstep; const char* cB = (const char*)g.Bt + (size_t)cur.pn * tstep;
    PG8_STAGE(PG8_SB(0, 0), cB, voffB); PG8_STAGE(PG8_SB(0, 1), cB + hstep, voffB); PG8_STAGE(PG8_SA(0, 0), cA, voffA); PG8_STAGE(PG8_SA(0, 1), cA + hstep, voffA);
    if (wr == 1) PG8_BAR;
    PG8_WAIT_V(2); PG8_BAR;
    PG8_STAGE(PG8_SB(1, 0), cB + kstep, voffB); PG8_STAGE(PG8_SA(1, 0), cA + kstep, voffA); PG8_STAGE(PG8_SB(1, 1), cB + hstep + kstep, voffB);
    PG8_WAIT_V(6); PG8_BAR;
    for (;;) {
        const bool has_next = S.next(ui + 1, nxt);
        const char* nA = has_next ? (const char*)g.A + (size_t)nxt.pm * tstep : cA; const char* nB = has_next ? (const char*)g.Bt + (size_t)nxt.pn * tstep : cB;
        for (int t = 0; t < nt; t += 2) {
            const bool last = (t == nt - 2);
            const char* a1 = cA + (size_t)(t + 1) * kstep;
            const char* a2 = last ? nA : cA + (size_t)(t + 2) * kstep; const char* b2 = last ? nB : cB + (size_t)(t + 2) * kstep;
            const char* a3 = a2 + kstep; const char* b3 = b2 + kstep;
            PG8_LDB(B0, 0, 0); PG8_LDB(B1, 0, 1); PG8_SCHED; PG8_LDA(At, 0, 0); PG8_STAGE(PG8_SA(1, 1), a1 + hstep, voffA);
            PG8_WAIT_V(8); PG8_WAIT_L(0); PG8_BAR; PG8_MMA(0, 0, At, B0); PG8_MMA(0, 1, At, B1); PG8_BAR; PG8_SCHED;
            PG8_LDA(At, 0, 1); PG8_STAGE(PG8_SB(0, 0), b2, voffB); PG8_STAGE(PG8_SB(0, 1), b2 + hstep, voffB); PG8_STAGE(PG8_SA(0, 0), a2, voffA);
            PG8_WAIT_V(8); PG8_WAIT_L(0); PG8_BAR; PG8_MMA(1, 0, At, B0); PG8_MMA(1, 1, At, B1); PG8_BAR; PG8_SCHED;
            PG8_LDB(B0, 1, 0); PG8_LDB(B1, 1, 1); PG8_SCHED; PG8_LDA(At, 1, 0); PG8_STAGE(PG8_SA(0, 1), a2 + hstep, voffA);
            PG8_WAIT_V(8); PG8_WAIT_L(0); PG8_BAR; PG8_MMA(0, 0, At, B0); PG8_MMA(0, 1, At, B1); PG8_BAR; PG8_SCHED;
            PG8_LDA(At, 1, 1); PG8_STAGE(PG8_SB(1, 0), b3, voffB); PG8_STAGE(PG8_SB(1, 1), b3 + hstep, voffB); PG8_STAGE(PG8_SA(1, 0), a3, voffA);
            PG8_WAIT_V(8); PG8_WAIT_L(0); PG8_BAR; PG8_MMA(1, 0, At, B0); PG8_MMA(1, 1, At, B1); PG8_BAR; PG8_SCHED;
        }
        if (wr == 0) PG8_BAR;
        E(acc, cur, wr, wc, fr, fq, lds, tid);
#ifdef DUP_EPI
        if constexpr (Epi::PERM && sizeof(Epi) == sizeof(EpiStore<2>)) { if (g.N == FF) E(acc, cur, wr, wc, fr, fq, lds, tid); }
#endif
        if (!has_next) break;
#pragma unroll
        for (int a = 0; a < 2; ++a)
#pragma unroll
            for (int b = 0; b < 2; ++b)
#pragma unroll
                for (int m = 0; m < 4; ++m)
#pragma unroll
                    for (int n = 0; n < 2; ++n) acc[a][b][m][n] = (f32x4){0.f, 0.f, 0.f, 0.f};
        cur = nxt; cA = nA; cB = nB; ++ui;
        if (wr == 1) PG8_BAR;
    }
    PG8_WAIT_V(0);
    PG8_BAR;
#undef PG8_SA
#undef PG8_SB
#undef PG8_STAGE
#undef PG8_LDA
#undef PG8_LDB
#undef PG8_MMA
#undef PG8_WAIT_V
#undef PG8_WAIT_L
#undef PG8_BAR
#undef PG8_SCHED
}
}

namespace att {
constexpr int KVBLK = 64;
constexpr int SHM_V = 16384, SHM_K = 16384;
constexpr int SLOT = 32768, L_V = 0, L_K = 16384, L_WS = 98304, L_TAB = 100352, L_EX = 0;
constexpr int TABN = 373, TABC = 186;
constexpr float THR = 12.f;
#define KSWZ(row, colB) ((row) * 256 + ((colB) ^ (((row) & 15) << 4)))
#define SBAR() __builtin_amdgcn_sched_barrier(0)
__device__ __forceinline__ int crow(int r, int hi) { return (r & 3) + 8 * (r >> 2) + 4 * hi; }

__device__ __forceinline__ void partialSM(f32x16& p0, f32x16& p1, float& e_reg, float& cbprev, float cb, float& alpha) {
  float pmax = p0[0];
#pragma unroll
  for (int r = 1; r < 16; ++r) pmax = fmaxf(pmax, p0[r]);
#pragma unroll
  for (int r = 0; r < 16; ++r) pmax = fmaxf(pmax, p1[r]);
  { auto rr = __builtin_amdgcn_permlane32_swap(__float_as_uint(pmax), __float_as_uint(pmax), false, false);
    pmax = fmaxf(__uint_as_float(rr[0]), __uint_as_float(rr[1])); }
  float sh = e_reg - cb;
  if (__builtin_expect(cb == cbprev && __all(pmax - sh <= THR), 1)) { alpha = 1.f; }
  else { const bool ok0 = (pmax <= THR) && (pmax >= -THR) && (sh <= THR);
    sh = ok0 ? 0.f : fmaxf(pmax, sh);
    const float en = sh + cb; alpha = __builtin_amdgcn_exp2f(e_reg - en); e_reg = en; }
  cbprev = cb;
  if (!__all(sh == 0.f)) {
#pragma unroll
    for (int r = 0; r < 16; ++r) p0[r] = p0[r] - sh;
#pragma unroll
    for (int r = 0; r < 16; ++r) p1[r] = p1[r] - sh;
  }
#pragma unroll
  for (int r = 0; r < 16; ++r) p0[r] = __builtin_amdgcn_exp2f(p0[r]);
#ifdef EXP_ALL_IN_PARTIAL
#pragma unroll
  for (int r = 0; r < 16; ++r) p1[r] = __builtin_amdgcn_exp2f(p1[r]);
#endif
}
__device__ __forceinline__ void finishSM(f32x16& p0, f32x16& p1, float alpha, float& l_reg, bf16x8& pa0, bf16x8& pa1, bf16x8& pa2, bf16x8& pa3) {
#ifndef EXP_ALL_IN_PARTIAL
#pragma unroll
  for (int r = 0; r < 16; ++r) p1[r] = __builtin_amdgcn_exp2f(p1[r]);
#endif
  float ps = 0;
#pragma unroll
  for (int r = 0; r < 16; ++r) ps += p0[r];
#pragma unroll
  for (int r = 0; r < 16; ++r) ps += p1[r];
  { auto rr = __builtin_amdgcn_permlane32_swap(__float_as_uint(ps), __float_as_uint(ps), false, false);
    ps = __uint_as_float(rr[0]) + __uint_as_float(rr[1]); }
  l_reg = l_reg * alpha + ps;
#define PK4(P, BASE, OUT) do { unsigned a0 = cvt_pk_bf16(P[BASE + 0], P[BASE + 1]), a1 = cvt_pk_bf16(P[BASE + 2], P[BASE + 3]);   \
    unsigned b0 = cvt_pk_bf16(P[BASE + 4], P[BASE + 5]), b1 = cvt_pk_bf16(P[BASE + 6], P[BASE + 7]);                              \
    auto r0 = __builtin_amdgcn_permlane32_swap(a0, b0, false, false); auto r1 = __builtin_amdgcn_permlane32_swap(a1, b1, false, false); \
    u32x4 w = {r0[0], r1[0], r0[1], r1[1]}; OUT = *reinterpret_cast<bf16x8*>(&w); } while (0)
  PK4(p0, 0, pa0); PK4(p0, 8, pa1); PK4(p1, 0, pa2); PK4(p1, 8, pa3);
#undef PK4
}
template <bool SEEDED> __device__ __forceinline__ void qkt(f32x16& p0, f32x16& p1, const char* Ks, const bf16x8* qr, int r32, int cbase) {
#pragma unroll
  for (int d0 = 0; d0 < 4; ++d0) { const int cb = cbase + d0 * 32;
    bf16x8 b0 = *reinterpret_cast<const bf16x8*>(Ks + KSWZ(r32, cb));
    bf16x8 b1 = *reinterpret_cast<const bf16x8*>(Ks + KSWZ(32 + r32, cb));
    if (!SEEDED && d0 == 0) { p0 = __builtin_amdgcn_mfma_f32_32x32x16_bf16(b0, qr[0], f32x16{}, 0, 0, 0); p1 = __builtin_amdgcn_mfma_f32_32x32x16_bf16(b1, qr[0], f32x16{}, 0, 0, 0); }
    else { p0 = __builtin_amdgcn_mfma_f32_32x32x16_bf16(b0, qr[d0], p0, 0, 0, 0); p1 = __builtin_amdgcn_mfma_f32_32x32x16_bf16(b1, qr[d0], p1, 0, 0, 0); } }
}
__device__ __forceinline__ int v_st(int k, int c) { const int kk = (k & ~0xC) | ((k & 4) << 1) | ((k & 8) >> 1); return ((kk >> 3) * 4 + (c >> 5)) * 512 + ((kk & 7) * 32 + (c & 31)) * 2; }
__device__ __forceinline__ int v_rd_base(int lane) { return ((lane & 3) << 3) | (((lane >> 2) & 3) << 6) | (((lane >> 4) & 1) << 5) | (((lane >> 5) & 1) << 8); }
constexpr int v_rd_off(int d0, int ks, int half) { return d0 * 512 + ks * 4096 + half * 2048; }
template <int OFF> __device__ __forceinline__ s16x4 tr_read(int vb) {
  s16x4 r; asm volatile("ds_read_b64_tr_b16 %0, %1 offset:%2" : "=&v"(r) : "v"(vb), "i"(OFF) : "memory"); return r;
}
template <int D0> __device__ __forceinline__ void pv_one(f32x16& od, int vb, bf16x8 pa0, bf16x8 pa1, bf16x8 pa2, bf16x8 pa3) {
  const s16x4 l0 = tr_read<v_rd_off(D0, 0, 0)>(vb), h0 = tr_read<v_rd_off(D0, 0, 1)>(vb), l1 = tr_read<v_rd_off(D0, 1, 0)>(vb), h1 = tr_read<v_rd_off(D0, 1, 1)>(vb);
  const s16x4 l2 = tr_read<v_rd_off(D0, 2, 0)>(vb), h2 = tr_read<v_rd_off(D0, 2, 1)>(vb), l3 = tr_read<v_rd_off(D0, 3, 0)>(vb), h3 = tr_read<v_rd_off(D0, 3, 1)>(vb);
  asm volatile("s_waitcnt lgkmcnt(0)" ::: "memory"); SBAR();
#define PK(L, H) (bf16x8){L[0], L[1], L[2], L[3], H[0], H[1], H[2], H[3]}
  od = __builtin_amdgcn_mfma_f32_32x32x16_bf16(pa0, PK(l0, h0), od, 0, 0, 0);
  od = __builtin_amdgcn_mfma_f32_32x32x16_bf16(pa1, PK(l1, h1), od, 0, 0, 0);
  od = __builtin_amdgcn_mfma_f32_32x32x16_bf16(pa2, PK(l2, h2), od, 0, 0, 0);
  od = __builtin_amdgcn_mfma_f32_32x32x16_bf16(pa3, PK(l3, h3), od, 0, 0, 0);
#undef PK
}
template <int D0> __device__ __forceinline__ void pv_reads(s16x4 (&L)[8], int vb) {
  L[0] = tr_read<v_rd_off(D0, 0, 0)>(vb); L[1] = tr_read<v_rd_off(D0, 0, 1)>(vb); L[2] = tr_read<v_rd_off(D0, 1, 0)>(vb); L[3] = tr_read<v_rd_off(D0, 1, 1)>(vb);
  L[4] = tr_read<v_rd_off(D0, 2, 0)>(vb); L[5] = tr_read<v_rd_off(D0, 2, 1)>(vb); L[6] = tr_read<v_rd_off(D0, 3, 0)>(vb); L[7] = tr_read<v_rd_off(D0, 3, 1)>(vb);
}
__device__ __forceinline__ void pv_mma(f32x16& od, const s16x4 (&L)[8], bf16x8 pa0, bf16x8 pa1, bf16x8 pa2, bf16x8 pa3) {
#define PK(A, B) (bf16x8){A[0], A[1], A[2], A[3], B[0], B[1], B[2], B[3]}
  od = __builtin_amdgcn_mfma_f32_32x32x16_bf16(pa0, PK(L[0], L[1]), od, 0, 0, 0);
  od = __builtin_amdgcn_mfma_f32_32x32x16_bf16(pa1, PK(L[2], L[3]), od, 0, 0, 0);
  od = __builtin_amdgcn_mfma_f32_32x32x16_bf16(pa2, PK(L[4], L[5]), od, 0, 0, 0);
  od = __builtin_amdgcn_mfma_f32_32x32x16_bf16(pa3, PK(L[6], L[7]), od, 0, 0, 0);
#undef PK
}
template <bool MEM> __device__ __forceinline__ void pv_all(f32x16* o, int vb, bf16x8 pa0, bf16x8 pa1, bf16x8 pa2, bf16x8 pa3) {
#ifndef NO_PV_PIPE
  s16x4 LA[8], LB[8];
  pv_reads<0>(LA, vb); pv_reads<1>(LB, vb);
  asm volatile("s_waitcnt lgkmcnt(8)" ::: "memory"); SBAR(); pv_mma(o[0], LA, pa0, pa1, pa2, pa3); SBAR();
  if constexpr (!MEM) {
    pv_reads<2>(LA, vb);
    asm volatile("s_waitcnt lgkmcnt(8)" ::: "memory"); SBAR(); pv_mma(o[1], LB, pa0, pa1, pa2, pa3); SBAR();
    pv_reads<3>(LB, vb);
    asm volatile("s_waitcnt lgkmcnt(8)" ::: "memory"); SBAR(); pv_mma(o[2], LA, pa0, pa1, pa2, pa3); SBAR();
    asm volatile("s_waitcnt lgkmcnt(0)" ::: "memory"); SBAR(); pv_mma(o[3], LB, pa0, pa1, pa2, pa3);
  } else {
    asm volatile("s_waitcnt lgkmcnt(0)" ::: "memory"); SBAR(); pv_mma(o[1], LB, pa0, pa1, pa2, pa3);
  }
#else
  pv_one<0>(o[0], vb, pa0, pa1, pa2, pa3); pv_one<1>(o[1], vb, pa0, pa1, pa2, pa3);
  if constexpr (!MEM) { pv_one<2>(o[2], vb, pa0, pa1, pa2, pa3); pv_one<3>(o[3], vb, pa0, pa1, pa2, pa3); }
#endif
}

template <bool MEM>
__device__ __forceinline__ void attn_unit(const bf16_t* __restrict__ Qg, int ldq, const bf16_t* __restrict__ Kg, const bf16_t* __restrict__ Vg, int ldk,
                                          bf16_t* __restrict__ Og, int q0pos, const LAS float* tab, float lam, float oscale, const float* __restrict__ gnorm, char* lds) {
  constexpr int NT = MEM ? (MEML / KVBLK) : (SEQ / KVBLK); constexpr int ND = MEM ? 2 : 4;
  const int tid = opaque_tid(), wid = __builtin_amdgcn_readfirstlane(tid >> 6), lane = tid & 63, r32 = lane & 31, hi = lane >> 5;
  const int half = wid >> 2, wq = wid & 3;
  char* V_lds = lds + L_V; char* K_lds = lds + L_K;
  float* ws = (float*)(lds + L_WS) + wid * 64; float* li_l = ws; float* al_l = ws + 32;
  float m_reg = -1e30f, l_reg = 0; f32x16 o[ND];
#pragma unroll
  for (int d = 0; d < ND; ++d) o[d] = f32x16{};
  bf16x8 qr[4];
  const bf16_t* Qw = Qg + (long)(wq * 32 + r32) * ldq + half * 64 + hi * 8;
#pragma unroll
  for (int d0 = 0; d0 < 4; ++d0) qr[d0] = *reinterpret_cast<const bf16x8*>(Qw + d0 * 16);
  const int vb0 = (int)(uintptr_t)V_lds + v_rd_base(lane) + (MEM ? half * 1024 : 0);
  const int cbase = half * 128 + hi * 16;
  const int q0w = q0pos + wq * 32;
  float cL = 0.f, cR = 0.f;
  if constexpr (!MEM) { cL = tab[0]; cR = tab[TABN - 1]; }
  unsigned koff[2], voff[2];
#pragma unroll
  for (int i = 0; i < 2; ++i) { const int p = 2 * wid + i;
    { const int row = 4 * p + (lane >> 4), chunk = (lane & 15) ^ (row & 15); koff[i] = (unsigned)(row * ldk + chunk * 8) * 2u; }
    { const int st = 2 * p + (lane >> 5), kk = (st >> 2) * 8 + ((lane >> 2) & 7), k = (kk & ~0xC) | ((kk & 4) << 1) | ((kk & 8) >> 1), c = (st & 3) * 32 + (lane & 3) * 8; voff[i] = (unsigned)(k * ldk + c) * 2u; } }
  LAS unsigned char* ldsA = (LAS unsigned char*)lds;
  const size_t tile_bytes = (size_t)KVBLK * ldk * 2;
#define DMA(t, sl) do { const char* kb_ = (const char*)Kg + (size_t)(t) * tile_bytes; const char* vb_ = (const char*)Vg + (size_t)(t) * tile_bytes; \
    _Pragma("unroll") for (int i_ = 0; i_ < 2; ++i_) { \
      __builtin_amdgcn_global_load_lds((const unsigned*)(kb_ + koff[i_]), (LAS unsigned*)(ldsA + (sl) + L_K + (2 * wid + i_) * 1024), 16, 0, 0); \
      __builtin_amdgcn_global_load_lds((const unsigned*)(vb_ + voff[i_]), (LAS unsigned*)(ldsA + (sl) + L_V + (2 * wid + i_) * 1024), 16, 0, 0); } } while (0)
#define BARRIER() asm volatile("s_waitcnt vmcnt(0) lgkmcnt(0)\n\ts_barrier" ::: "memory")
#define RESC(a) do { if (__any((a) != 1.f)) { if (hi == 0) al_l[r32] = (a); asm volatile("s_waitcnt lgkmcnt(0)" ::: "memory"); \
    _Pragma("unroll") for (int d = 0; d < ND; ++d) _Pragma("unroll") for (int r = 0; r < 16; ++r) o[d][r] *= al_l[crow(r, hi)]; } } while (0)
#define SCORES_FIN(P0, P1, CB, Kbuf, j, FIN) do { bool band_ = false; int dq_ = 0; if constexpr (!MEM) { dq_ = (j) * KVBLK - q0w; band_ = (dq_ >= -128 && dq_ <= 96); } \
    if (band_) { const LAS float* tb = tab + (dq_ + 4 * hi - r32 + TABC); \
      _Pragma("unroll") for (int r = 0; r < 16; ++r) { P0[r] = tb[(r & 3) + 8 * (r >> 2)]; P1[r] = tb[32 + (r & 3) + 8 * (r >> 2)]; } \
      CB = 0.f; SBAR(); qkt<true>(P0, P1, Kbuf, qr, r32, cbase); FIN; SBAR(); } \
    else { CB = MEM ? 0.f : (dq_ > 0 ? cR : cL); SBAR(); qkt<false>(P0, P1, Kbuf, qr, r32, cbase); FIN; SBAR(); } } while (0)
#define SCORES(P0, P1, CB, Kbuf, j) SCORES_FIN(P0, P1, CB, Kbuf, j, (void)0)
  f32x16 pA0, pA1, pB0, pB1; float alA, alB, cbA, cbB, cbprev = 0.f; bf16x8 pa0, pa1, pa2, pa3;
  int sl_prev = 0, sl_cur = SLOT, sl_next = 2 * SLOT;
#define ROT() do { const int t_ = sl_prev; sl_prev = sl_cur; sl_cur = sl_next; sl_next = t_; } while (0)
#define STEP(PC0, PC1, ALC, CBC, PP0, PP1, ALP, j) do { BARRIER(); if ((j) + 1 < NT) DMA((j) + 1, sl_next); \
    SCORES_FIN(PC0, PC1, CBC, K_lds + sl_cur, j, finishSM(PP0, PP1, ALP, l_reg, pa0, pa1, pa2, pa3)); \
    pv_all<MEM>(o, vb0 + sl_prev, pa0, pa1, pa2, pa3); partialSM(PC0, PC1, m_reg, cbprev, CBC, ALC); \
    RESC(ALC); ROT(); } while (0)
  DMA(0, 0); DMA(1, SLOT);
  BARRIER();
  SCORES(pA0, pA1, cbA, K_lds, 0); partialSM(pA0, pA1, m_reg, cbprev, cbA, alA);
  for (int j = 1; j + 1 < NT; j += 2) {
    STEP(pB0, pB1, alB, cbB, pA0, pA1, alA, j);
    STEP(pA0, pA1, alA, cbA, pB0, pB1, alB, j + 1);
  }
  STEP(pB0, pB1, alB, cbB, pA0, pA1, alA, NT - 1);
  finishSM(pB0, pB1, alB, l_reg, pa0, pa1, pa2, pa3); SBAR();
  pv_all<MEM>(o, vb0 + sl_prev, pa0, pa1, pa2, pa3);
  BARRIER();
  if (hi == 0) li_l[r32] = l_reg; asm volatile("s_waitcnt lgkmcnt(0)" ::: "memory");
  float rli[16];
#pragma unroll
  for (int r = 0; r < 16; ++r) rli[r] = __builtin_amdgcn_rcpf(li_l[crow(r, hi)]);
  if constexpr (MEM) {
    bf16_t* Ow = Og + (long)(wq * 32) * DM + half * 64;
#pragma unroll
    for (int r = 0; r < 16; ++r) { const int orow = crow(r, hi);
#pragma unroll
      for (int d0 = 0; d0 < 2; ++d0) Ow[(long)orow * DM + d0 * 32 + r32] = (bf16_t)(cvt_pk_bf16(o[d0][r] * rli[r], 0.f) & 0xffffu); }
  } else {
    LAS float* ex = (LAS float*)((LAS char*)lds + L_EX) + wq * 4096 + lane;
    if (half == 1) {
#pragma unroll
      for (int d0 = 0; d0 < 4; ++d0)
#pragma unroll
        for (int r = 0; r < 16; ++r) ex[(d0 * 16 + r) * 64] = o[d0][r] * rli[r];
    }
    __syncthreads();
    if (half == 0) {
      float ss[16];
#pragma unroll
      for (int r = 0; r < 16; ++r) { float s = 0.f;
#pragma unroll
        for (int d0 = 0; d0 < 4; ++d0) { const float x = o[d0][r] * rli[r] - lam * ex[(d0 * 16 + r) * 64]; o[d0][r] = x; s += x * x; }
        ss[r] = s; }
#pragma unroll
      for (int off = 1; off < 32; off <<= 1)
#pragma unroll
        for (int r = 0; r < 16; ++r) ss[r] += shfl_xor_f(ss[r], off);
      float gv[4];
#pragma unroll
      for (int d0 = 0; d0 < 4; ++d0) gv[d0] = gnorm[d0 * 32 + r32] * oscale;
      bf16_t* Ow = Og + (long)(wq * 32) * DM;
#pragma unroll
      for (int r = 0; r < 16; ++r) { const int orow = crow(r, hi); const float rs = __builtin_amdgcn_rsqf(ss[r] * (1.f / 128.f) + LN_EPS);
#pragma unroll
        for (int d0 = 0; d0 < 4; ++d0) Ow[(long)orow * DM + d0 * 32 + r32] = (bf16_t)(cvt_pk_bf16(o[d0][r] * rs * gv[d0], 0.f) & 0xffffu); }
    }
  }
  if constexpr (!MEM) BARRIER();
#undef DMA
#undef BARRIER
#undef STEP
#undef ROT
#undef RESC
#undef SCORES
#undef SCORES_FIN
}
template <int D0> __device__ __forceinline__ void pv_rd(s16x4 (&L)[8], int vb) {
  L[0] = tr_read<v_rd_off(D0, 0, 0)>(vb); L[1] = tr_read<v_rd_off(D0, 0, 1)>(vb); L[2] = tr_read<v_rd_off(D0, 1, 0)>(vb); L[3] = tr_read<v_rd_off(D0, 1, 1)>(vb);
  L[4] = tr_read<v_rd_off(D0, 2, 0)>(vb); L[5] = tr_read<v_rd_off(D0, 2, 1)>(vb); L[6] = tr_read<v_rd_off(D0, 3, 0)>(vb); L[7] = tr_read<v_rd_off(D0, 3, 1)>(vb);
}
__device__ __forceinline__ void pv_mma2(f32x16& oa, f32x16& ob, const s16x4 (&L)[8], const bf16x8 (&pa)[4], const bf16x8 (&pb)[4]) {
#define PKV(a) (bf16x8){L[a][0], L[a][1], L[a][2], L[a][3], L[(a) + 1][0], L[(a) + 1][1], L[(a) + 1][2], L[(a) + 1][3]}
  oa = __builtin_amdgcn_mfma_f32_32x32x16_bf16(pa[0], PKV(0), oa, 0, 0, 0); ob = __builtin_amdgcn_mfma_f32_32x32x16_bf16(pb[0], PKV(0), ob, 0, 0, 0);
  oa = __builtin_amdgcn_mfma_f32_32x32x16_bf16(pa[1], PKV(2), oa, 0, 0, 0); ob = __builtin_amdgcn_mfma_f32_32x32x16_bf16(pb[1], PKV(2), ob, 0, 0, 0);
  oa = __builtin_amdgcn_mfma_f32_32x32x16_bf16(pa[2], PKV(4), oa, 0, 0, 0); ob = __builtin_amdgcn_mfma_f32_32x32x16_bf16(pb[2], PKV(4), ob, 0, 0, 0);
  oa = __builtin_amdgcn_mfma_f32_32x32x16_bf16(pa[3], PKV(6), oa, 0, 0, 0); ob = __builtin_amdgcn_mfma_f32_32x32x16_bf16(pb[3], PKV(6), ob, 0, 0, 0);
#undef PKV
}
template <bool MEM> __device__ __forceinline__ void pv_all2(f32x16* oa, f32x16* ob, int vb, const bf16x8 (&pa)[4], const bf16x8 (&pb)[4]) {
  s16x4 LA[8], LB[8];
  pv_rd<0>(LA, vb); pv_rd<1>(LB, vb);
  asm volatile("s_waitcnt lgkmcnt(8)" ::: "memory"); SBAR(); pv_mma2(oa[0], ob[0], LA, pa, pb); SBAR();
  if constexpr (!MEM) {
    pv_rd<2>(LA, vb);
    asm volatile("s_waitcnt lgkmcnt(8)" ::: "memory"); SBAR(); pv_mma2(oa[1], ob[1], LB, pa, pb); SBAR();
    pv_rd<3>(LB, vb);
    asm volatile("s_waitcnt lgkmcnt(8)" ::: "memory"); SBAR(); pv_mma2(oa[2], ob[2], LA, pa, pb); SBAR();
    asm volatile("s_waitcnt lgkmcnt(0)" ::: "memory"); SBAR(); pv_mma2(oa[3], ob[3], LB, pa, pb);
  } else {
    asm volatile("s_waitcnt lgkmcnt(0)" ::: "memory"); SBAR(); pv_mma2(oa[1], ob[1], LB, pa, pb);
  }
}
template <bool SA, bool SB>
__device__ __forceinline__ void qkt2(f32x16& a0, f32x16& a1, f32x16& b0, f32x16& b1, const char* Ks, const LAS bf16x8* qp, int r32, int cbase) {
#pragma unroll
  for (int d0 = 0; d0 < 4; ++d0) { const int cb = cbase + d0 * 32;
    const bf16x8 k0 = *reinterpret_cast<const bf16x8*>(Ks + KSWZ(r32, cb)), k1 = *reinterpret_cast<const bf16x8*>(Ks + KSWZ(32 + r32, cb));
    const bf16x8 qa = qp[d0 * 64], qb = qp[(4 + d0) * 64];
    if (!SA && d0 == 0) { a0 = __builtin_amdgcn_mfma_f32_32x32x16_bf16(k0, qa, f32x16{}, 0, 0, 0); a1 = __builtin_amdgcn_mfma_f32_32x32x16_bf16(k1, qa, f32x16{}, 0, 0, 0); }
    else { a0 = __builtin_amdgcn_mfma_f32_32x32x16_bf16(k0, qa, a0, 0, 0, 0); a1 = __builtin_amdgcn_mfma_f32_32x32x16_bf16(k1, qa, a1, 0, 0, 0); }
    if (!SB && d0 == 0) { b0 = __builtin_amdgcn_mfma_f32_32x32x16_bf16(k0, qb, f32x16{}, 0, 0, 0); b1 = __builtin_amdgcn_mfma_f32_32x32x16_bf16(k1, qb, f32x16{}, 0, 0, 0); }
    else { b0 = __builtin_amdgcn_mfma_f32_32x32x16_bf16(k0, qb, b0, 0, 0, 0); b1 = __builtin_amdgcn_mfma_f32_32x32x16_bf16(k1, qb, b1, 0, 0, 0); } }
}
constexpr int L2_KRING = 49152, L2_WS = 81920, L2_TAB = 83968, L2_EX = 90112;
template <bool MEM>
__device__ __forceinline__ void attn_unit2(const bf16_t* __restrict__ Qg, int ldq, const bf16_t* __restrict__ Kg, const bf16_t* __restrict__ Vg, int ldk,
                                           bf16_t* __restrict__ Og, int q0pos, const LAS float* tab, float lam, float oscale, const float* __restrict__ gnorm, char* lds) {
  constexpr int NT = MEM ? (MEML / KVBLK) : (SEQ / KVBLK); constexpr int ND = MEM ? 2 : 4;
  const int tid = opaque_tid(), wid = __builtin_amdgcn_readfirstlane(tid >> 6), lane = tid & 63, r32 = lane & 31, hi = lane >> 5;
  const int half = wid >> 2, wq = wid & 3;
  char* V_lds = lds; char* K_lds = lds + L2_KRING;
  float* ws = (float*)(lds + L2_WS) + wid * 64; float* li_l = ws; float* al_l = ws + 32;
  float mA = -1e30f, mB = -1e30f, lA = 0.f, lB = 0.f, cbpA = 0.f, cbpB = 0.f; f32x16 oA[ND], oB[ND];
#pragma unroll
  for (int d = 0; d < ND; ++d) { oA[d] = f32x16{}; oB[d] = f32x16{}; }
  LAS bf16x8* qpark = (LAS bf16x8*)((LAS char*)lds + L2_EX) + wid * 512 + lane;
  { const bf16_t* Qw = Qg + (long)(wq * 64 + r32) * ldq + half * 64 + hi * 8;
#pragma unroll
    for (int d0 = 0; d0 < 4; ++d0) { qpark[d0 * 64] = *reinterpret_cast<const bf16x8*>(Qw + d0 * 16); qpark[(4 + d0) * 64] = *reinterpret_cast<const bf16x8*>(Qw + (long)32 * ldq + d0 * 16); } }
  const int vb0 = (int)(uintptr_t)V_lds + v_rd_base(lane) + (MEM ? half * 1024 : 0);
  const int cbase = half * 128 + hi * 16;
  const int q0wA = q0pos + wq * 64, q0wB = q0wA + 32;
  float cL = 0.f, cR = 0.f;
  if constexpr (!MEM) { cL = tab[0]; cR = tab[TABN - 1]; }
  unsigned koff[2], voff[2];
#pragma unroll
  for (int i = 0; i < 2; ++i) { const int p = 2 * wid + i;
    { const int row = 4 * p + (lane >> 4), chunk = (lane & 15) ^ (row & 15); koff[i] = (unsigned)(row * ldk + chunk * 8) * 2u; }
    { const int st = 2 * p + (lane >> 5), kk = (st >> 2) * 8 + ((lane >> 2) & 7), k = (kk & ~0xC) | ((kk & 4) << 1) | ((kk & 8) >> 1), c = (st & 3) * 32 + (lane & 3) * 8; voff[i] = (unsigned)(k * ldk + c) * 2u; } }
  LAS unsigned char* ldsA = (LAS unsigned char*)lds;
  const size_t tile_bytes = (size_t)KVBLK * ldk * 2;
#define DMA(t, ksl, vsl) do { const char* kb_ = (const char*)Kg + (size_t)(t) * tile_bytes; const char* vb_ = (const char*)Vg + (size_t)(t) * tile_bytes; \
    _Pragma("unroll") for (int i_ = 0; i_ < 2; ++i_) { \
      __builtin_amdgcn_global_load_lds((const unsigned*)(kb_ + koff[i_]), (LAS unsigned*)(ldsA + L2_KRING + (ksl) + (2 * wid + i_) * 1024), 16, 0, 0); \
      __builtin_amdgcn_global_load_lds((const unsigned*)(vb_ + voff[i_]), (LAS unsigned*)(ldsA + (vsl) + (2 * wid + i_) * 1024), 16, 0, 0); } } while (0)
#define BARRIER() asm volatile("s_waitcnt vmcnt(0) lgkmcnt(0)\n\ts_barrier" ::: "memory")
#define RESC2(O, a) do { if (__any((a) != 1.f)) { if (hi == 0) al_l[r32] = (a); asm volatile("s_waitcnt lgkmcnt(0)" ::: "memory"); \
    _Pragma("unroll") for (int d = 0; d < ND; ++d) _Pragma("unroll") for (int r = 0; r < 16; ++r) O[d][r] *= al_l[crow(r, hi)]; } } while (0)
#define SEEDT(C0, C1, DQ) do { const LAS float* tb = tab + ((DQ) + 4 * hi - r32 + TABC); \
    _Pragma("unroll") for (int r = 0; r < 16; ++r) { C0[r] = tb[(r & 3) + 8 * (r >> 2)]; C1[r] = tb[32 + (r & 3) + 8 * (r >> 2)]; } } while (0)
#define SMONLY(PA, C0, C1, CB, O, L_, M_, CBP) do { float al_; partialSM(C0, C1, M_, CBP, CB, al_); RESC2(O, al_); \
    finishSM(C0, C1, al_, L_, PA[0], PA[1], PA[2], PA[3]); SBAR(); } while (0)
#define QKSM(j, sl) do { f32x16 a0_, a1_, b0_, b1_; float cba_ = 0.f, cbb_ = 0.f; \
    if constexpr (MEM) { qkt2<false, false>(a0_, a1_, b0_, b1_, K_lds + (sl), qpark, r32, cbase); } \
    else { const int dqa_ = (j) * KVBLK - q0wA, dqb_ = dqa_ - 32; const bool ba_ = (dqa_ >= -128 && dqa_ <= 96), bb_ = (dqb_ >= -128 && dqb_ <= 96); \
      cba_ = ba_ ? 0.f : (dqa_ > 0 ? cR : cL); cbb_ = bb_ ? 0.f : (dqb_ > 0 ? cR : cL); \
      if (!ba_ && !bb_) { qkt2<false, false>(a0_, a1_, b0_, b1_, K_lds + (sl), qpark, r32, cbase); } \
      else if (ba_ && bb_) { SEEDT(a0_, a1_, dqa_); SEEDT(b0_, b1_, dqb_); qkt2<true, true>(a0_, a1_, b0_, b1_, K_lds + (sl), qpark, r32, cbase); } \
      else if (ba_) { SEEDT(a0_, a1_, dqa_); qkt2<true, false>(a0_, a1_, b0_, b1_, K_lds + (sl), qpark, r32, cbase); } \
      else { SEEDT(b0_, b1_, dqb_); qkt2<false, true>(a0_, a1_, b0_, b1_, K_lds + (sl), qpark, r32, cbase); } } \
    SMONLY(pA_, a0_, a1_, cba_, oA, lA, mA, cbpA); \
    SMONLY(pB_, b0_, b1_, cbb_, oB, lB, mB, cbpB); } while (0)
  bf16x8 pA_[4], pB_[4];
  int v_prev = 0, v_cur = 0, v_next = 16384;
#define VROT() do { v_prev = v_cur; v_cur = v_next; v_next = (v_next == 32768) ? 0 : v_next + 16384; } while (0)
  DMA(0, 0, 0);
  if (half == 0) {
    for (int j = 0; j < NT; ++j) { const int ksl = (j & 1) * 16384;
      BARRIER(); if (j + 1 < NT) DMA(j + 1, 16384 - ksl, v_next);
      QKSM(j, ksl);
      pv_all2<MEM>(oA, oB, vb0 + v_cur, pA_, pB_); VROT(); }
  } else {
    for (int j = 0; j < NT; ++j) { const int ksl = (j & 1) * 16384;
      BARRIER(); if (j + 1 < NT) DMA(j + 1, 16384 - ksl, v_next);
      if (j > 0) pv_all2<MEM>(oA, oB, vb0 + v_prev, pA_, pB_);
      QKSM(j, ksl); VROT(); }
    pv_all2<MEM>(oA, oB, vb0 + v_prev, pA_, pB_);
  }
  BARRIER();
#define EPI(O, L_, RB) do { if (hi == 0) li_l[r32] = (L_); asm volatile("s_waitcnt lgkmcnt(0)" ::: "memory"); \
    float rli[16]; _Pragma("unroll") for (int r = 0; r < 16; ++r) rli[r] = __builtin_amdgcn_rcpf(li_l[crow(r, hi)]); \
    if constexpr (MEM) { bf16_t* Ow = Og + (long)(wq * 64 + (RB)) * DM + half * 64; \
      _Pragma("unroll") for (int r = 0; r < 16; ++r) { const int orow = crow(r, hi); \
        _Pragma("unroll") for (int d0 = 0; d0 < 2; ++d0) Ow[(long)orow * DM + d0 * 32 + r32] = (bf16_t)(cvt_pk_bf16(O[d0][r] * rli[r], 0.f) & 0xffffu); } } \
    else { LAS float* ex = (LAS float*)((LAS char*)lds + L2_EX) + wq * 4096 + lane; \
      if (half == 1) { _Pragma("unroll") for (int d0 = 0; d0 < 4; ++d0) _Pragma("unroll") for (int r = 0; r < 16; ++r) ex[(d0 * 16 + r) * 64] = O[d0][r] * rli[r]; } \
      __syncthreads(); \
      if (half == 0) { float ss[16]; \
        _Pragma("unroll") for (int r = 0; r < 16; ++r) { float s = 0.f; \
          _Pragma("unroll") for (int d0 = 0; d0 < 4; ++d0) { const float x = O[d0][r] * rli[r] - lam * ex[(d0 * 16 + r) * 64]; O[d0][r] = x; s += x * x; } ss[r] = s; } \
        _Pragma("unroll") for (int off = 1; off < 32; off <<= 1) _Pragma("unroll") for (int r = 0; r < 16; ++r) ss[r] += shfl_xor_f(ss[r], off); \
        float gv[4]; _Pragma("unroll") for (int d0 = 0; d0 < 4; ++d0) gv[d0] = gnorm[d0 * 32 + r32] * oscale; \
        bf16_t* Ow = Og + (long)(wq * 64 + (RB)) * DM; \
        _Pragma("unroll") for (int r = 0; r < 16; ++r) { const int orow = crow(r, hi); const float rs = __builtin_amdgcn_rsqf(ss[r] * (1.f / 128.f) + LN_EPS); \
          _Pragma("unroll") for (int d0 = 0; d0 < 4; ++d0) Ow[(long)orow * DM + d0 * 32 + r32] = (bf16_t)(cvt_pk_bf16(O[d0][r] * rs * gv[d0], 0.f) & 0xffffu); } } \
      __syncthreads(); } } while (0)
  EPI(oA, lA, 0);
  EPI(oB, lB, 32);
#undef EPI
#undef QKSM
#undef VROT
#undef SMONLY
#undef SEEDT
#undef RESC2
#undef DMA
#undef BARRIER
}
#undef SBAR
}

struct Args {
    const float* x; const float* mem; const float* emb_g; const float* emb_b; const float* rel_bias;
    const float* w_in; const float* b_in; const float* conv_w; const float* conv_b; const float* conv_ln_g; const float* conv_ln_b;
    const float* lq1; const float* lk1; const float* lq2; const float* lk2; const float* diff_g; const float* w_mkv;
    const float* w_out; const float* b_out; const float* ln1_g; const float* ln1_b; const float* w_up; const float* w_down; const float* ln2_g; const float* ln2_b;
    float* out; unsigned char* ws;
    float lam_init[4];
};

__device__ __forceinline__ void transpose_item(const float* __restrict__ W, int K, int N, bf16_t* __restrict__ WT, int row_off, LAS float* scr, int item, int lane,
                                               const float* __restrict__ gk, const float* __restrict__ bk, float* __restrict__ pu, float* __restrict__ pv) {
    const int nblk = N / 32, kb = item / nblk, nb = item % nblk, k0 = 64 * kb, n0 = 32 * nb;
    LAS float* sg = scr + 64 * 33;
    { const int c4 = (lane & 7) * 4, r8 = lane >> 3;
      f32x4 t[8];
#pragma unroll
      for (int i = 0; i < 8; ++i) t[i] = *(const f32x4*)(W + (size_t)(k0 + 8 * i + r8) * N + n0 + c4);
#pragma unroll
      for (int i = 0; i < 8; ++i) { LAS float* d = scr + (8 * i + r8) * 33 + c4; d[0] = t[i].x; d[1] = t[i].y; d[2] = t[i].z; d[3] = t[i].w; } }
    if (gk) { sg[lane] = gk[k0 + lane]; sg[64 + lane] = bk[k0 + lane]; } else { sg[lane] = 1.f; }
    asm volatile("s_waitcnt lgkmcnt(0)" ::: "memory");
    const int c = lane & 7;
    float g8[8];
#pragma unroll
    for (int i = 0; i < 8; ++i) g8[i] = sg[8 * c + i];
#pragma unroll
    for (int j = 0; j < 4; ++j) { const int n = (lane >> 3) + 8 * j; const LAS float* s = scr + (8 * c) * 33 + n;
        u32x4 o; o.x = cvt_pk_bf16(s[0 * 33] * g8[0], s[1 * 33] * g8[1]); o.y = cvt_pk_bf16(s[2 * 33] * g8[2], s[3 * 33] * g8[3]);
        o.z = cvt_pk_bf16(s[4 * 33] * g8[4], s[5 * 33] * g8[5]); o.w = cvt_pk_bf16(s[6 * 33] * g8[6], s[7 * 33] * g8[7]);
        *(u32x4*)(WT + (size_t)(row_off + n0 + n) * K + k0 + 8 * c) = o; }
    if (gk) { const int nn = lane & 31, hf = lane >> 5; float su = 0.f, sv = 0.f;
#pragma unroll 8
        for (int k = 0; k < 32; ++k) { const int kk = hf * 32 + k; const float w = scr[kk * 33 + nn];
            su += __uint_as_float(cvt_pk_bf16(w * sg[kk], 0.f) << 16); sv += w * sg[64 + kk]; }
        su += shfl_xor_f(su, 32); sv += shfl_xor_f(sv, 32);
        if (lane < 32) { pu[(size_t)kb * N + n0 + nn] = su; pv[(size_t)kb * N + n0 + nn] = sv; } }
    asm volatile("s_waitcnt lgkmcnt(0)" ::: "memory");
}
__device__ __forceinline__ void ln_row(const float* xrow, float* of, bf16_t* ob, const float* __restrict__ g, const float* __restrict__ b, int lane) {
    const f32x4* xr = (const f32x4*)xrow + lane;
    f32x4 v[4]; float s = 0.f;
#pragma unroll
    for (int j = 0; j < 4; ++j) { v[j] = xr[64 * j]; s += (v[j].x + v[j].y) + (v[j].z + v[j].w); }
    const float mean = wave_sum(s) * (1.f / DM); float s2 = 0.f;
#pragma unroll
    for (int j = 0; j < 4; ++j) { v[j] = v[j] - mean; s2 += (v[j].x * v[j].x + v[j].y * v[j].y) + (v[j].z * v[j].z + v[j].w * v[j].w); }
    const float rstd = __builtin_amdgcn_rsqf(wave_sum(s2) * (1.f / DM) + LN_EPS);
#pragma unroll
    for (int j = 0; j < 4; ++j) { const f32x4 gg = ((const f32x4*)g)[lane + 64 * j], bb = ((const f32x4*)b)[lane + 64 * j];
        const f32x4 y = v[j] * rstd * gg + bb;
        ((f32x4*)of)[lane + 64 * j] = y;
        u32x2 w; w.x = cvt_pk_bf16(y.x, y.y); w.y = cvt_pk_bf16(y.z, y.w); ((u32x2*)ob)[lane + 64 * j] = w; }
}
__device__ __forceinline__ void ln_phase(const float* src, float* dstf, bf16_t* dstb, const float* g, const float* b, int gw, int ngw, int lane_) {
    const int lane = opaque_tid() & 63; (void)lane_;
    for (int m = gw; m < MTOK; m += ngw) ln_row(src + (size_t)m * DM, dstf + (size_t)m * DM, dstb + (size_t)m * DM, g, b, lane);
}
__device__ __forceinline__ void copy_stats_phase(const float* src, bf16_t* dstb, float* st, int gw, int ngw) {
    const int lane = opaque_tid() & 63;
    for (int m = gw; m < MTOK; m += ngw) {
        const f32x4* xr = (const f32x4*)(src + (size_t)m * DM) + lane;
        f32x4 v[4];
#pragma unroll
        for (int j = 0; j < 4; ++j) v[j] = xr[64 * j];
        float sj[4], qj[4];
#pragma unroll
        for (int j = 0; j < 4; ++j) { sj[j] = wave_sum((v[j].x + v[j].y) + (v[j].z + v[j].w)); qj[j] = wave_sum((v[j].x * v[j].x + v[j].y * v[j].y) + (v[j].z * v[j].z + v[j].w * v[j].w)); }
#pragma unroll
        for (int j = 0; j < 4; ++j) { u32x2 w; w.x = cvt_pk_bf16(v[j].x, v[j].y); w.y = cvt_pk_bf16(v[j].z, v[j].w); ((u32x2*)(dstb + (size_t)m * DM))[lane + 64 * j] = w; }
        if (lane == 0) { *(f32x4*)(st + (size_t)m * 8) = (f32x4){sj[0], qj[0], sj[1], qj[1]}; *(f32x4*)(st + (size_t)m * 8 + 4) = (f32x4){sj[2], qj[2], sj[3], qj[3]}; }
    }
}
__device__ __forceinline__ void ln_final_phase(const bf16_t* tb, const float* st, const float* g, const float* b, float* out, int gw, int ngw) {
    const int lane = opaque_tid() & 63;
    for (int m = gw; m < MTOK; m += ngw) {
        float mu, rs; pg8::row_mean_rstd(st, m, mu, rs);
#pragma unroll
        for (int j = 0; j < 4; ++j) { const u32x2 w = ((const u32x2*)(tb + (size_t)m * DM))[lane + 64 * j];
            const f32x4 x = {__uint_as_float(w.x << 16), __uint_as_float(w.x & 0xffff0000u), __uint_as_float(w.y << 16), __uint_as_float(w.y & 0xffff0000u)};
            const f32x4 gg = ((const f32x4*)g)[lane + 64 * j], bb = ((const f32x4*)b)[lane + 64 * j];
            ((f32x4*)(out + (size_t)m * DM))[lane + 64 * j] = (x - mu) * rs * gg + bb; }
    }
}
__device__ __forceinline__ int t5_bucket(int rel) {
    const int n = rel < 0 ? -rel : rel; int b = rel > 0 ? 16 : 0;
    if (n < 8) return b + n;
    int lg = 2 + (31 - __clz(n * n)); if (lg > 15) lg = 15;
    return b + lg;
}

__device__ __forceinline__ void conv_unit(const bf16_t* __restrict__ proj, bf16_t* __restrict__ mixed, const float* __restrict__ cw, const float* __restrict__ cb,
                                          const float* __restrict__ lg, const float* __restrict__ lb, int unit, LAS float* U) {
    const int tid = opaque_tid(), lane = tid & 63, wid = tid >> 6;
    const int b = unit >> 7, t0 = (unit & 127) * 32;
    LAS float* Y = U + 62 * 256;
    for (int task = tid; task < 62 * 32; task += 512) {
        const int rr = task >> 5, ch = (task & 31) * 8; const int t = t0 - 15 + rr;
        f32x4 u0 = {0.f, 0.f, 0.f, 0.f}, u1 = {0.f, 0.f, 0.f, 0.f};
        if (t >= 0 && t < SEQ) {
            const bf16_t* p = proj + (size_t)(b * SEQ + t) * INW + ch;
            const bf16x8 av = *(const bf16x8*)p, gv = *(const bf16x8*)(p + CONVC);
            float uu[8];
#pragma unroll
            for (int i = 0; i < 8; ++i) { const float a = bf2f((unsigned short)av[i]), g = bf2f((unsigned short)gv[i]); uu[i] = a * __builtin_amdgcn_rcpf(1.f + __expf(-g)); }
            u0 = (f32x4){uu[0], uu[1], uu[2], uu[3]}; u1 = (f32x4){uu[4], uu[5], uu[6], uu[7]};
        }
        *(LAS f32x4*)(U + rr * 256 + ch) = u0; *(LAS f32x4*)(U + rr * 256 + ch + 4) = u1;
    }
    __syncthreads();
    const int c = tid & 255, th = tid >> 8;
    float w[CONVW];
#pragma unroll
    for (int j = 0; j < CONVW; ++j) w[j] = cw[j * CONVC + c];
    const float bias = cb[c];
    const LAS float* Ub = U + (th * 16) * 256 + c;
    float uw[46];
#pragma unroll
    for (int i = 0; i < 46; ++i) uw[i] = Ub[i * 256];
#pragma unroll
    for (int t = 0; t < 16; ++t) {
        float s0 = bias, s1 = 0.f;
#pragma unroll
        for (int j = 0; j < CONVW; j += 2) { s0 += w[j] * uw[t + j]; if (j + 1 < CONVW) s1 += w[j + 1] * uw[t + j + 1]; }
        Y[(th * 16 + t) * 256 + c] = s0 + s1;
    }
    __syncthreads();
    const f32x4 gg = ((const f32x4*)lg)[lane], bb = ((const f32x4*)lb)[lane];
#pragma unroll
    for (int k = 0; k < 4; ++k) { const int tok = wid * 4 + k;
        f32x4 y = *(const LAS f32x4*)(Y + tok * 256 + lane * 4);
        const float mean = wave_sum((y.x + y.y) + (y.z + y.w)) * (1.f / 256.f); y = y - mean;
        const float rstd = __builtin_amdgcn_rsqf(wave_sum((y.x * y.x + y.y * y.y) + (y.z * y.z + y.w * y.w)) * (1.f / 256.f) + LN_EPS);
        y = y * rstd * gg + bb;
        f32x4 z; z.x = y.x * __builtin_amdgcn_rcpf(1.f + __expf(-y.x)); z.y = y.y * __builtin_amdgcn_rcpf(1.f + __expf(-y.y));
        z.z = y.z * __builtin_amdgcn_rcpf(1.f + __expf(-y.z)); z.w = y.w * __builtin_amdgcn_rcpf(1.f + __expf(-y.w));
        u32x2 o; o.x = cvt_pk_bf16(z.x, z.y); o.y = cvt_pk_bf16(z.z, z.w);
        *(u32x2*)(mixed + (size_t)(b * SEQ + t0 + tok) * DM + lane * 4) = o; }
    __syncthreads();
}

#define XB_TMO      128
#define XB_XCNT(j)  (256  + 64 * (j))
#define XB_XSUB(j)  (1280 + 64 * (j))
#define XB_XGEN(j)  (2304 + 64 * (j))
#define XB_TOP      3328
#define XB_TOPGEN   3392
#define XCD_BAR_WORDS 3456
#define XB_SPIN_CAP (1u << 18)
__device__ __forceinline__ unsigned xb_ld(unsigned* p)              { return __hip_atomic_load(p, __ATOMIC_RELAXED, __HIP_MEMORY_SCOPE_AGENT); }
__device__ __forceinline__ unsigned xb_add(unsigned* p, unsigned v) { return __hip_atomic_fetch_add(p, v, __ATOMIC_RELAXED, __HIP_MEMORY_SCOPE_AGENT); }
__device__ __forceinline__ unsigned xb_xcc_id() { return (unsigned)__builtin_amdgcn_s_getreg((3 << 11) | 20) & 0xFu; }
#define XB_SPIN(cond, bar) do { unsigned _sp = 0; while (cond) { __builtin_amdgcn_s_sleep(1); \
    if ((++_sp & 255u) == 0u) { if (xb_ld(&(bar)[XB_TMO])) break; if (_sp > XB_SPIN_CAP) { atomicAdd(&(bar)[XB_TMO], 1u); break; } } } } while (0)
struct XcdBarrier { unsigned* bar; unsigned x; volatile LAS unsigned* st; };
__device__ __forceinline__ XcdBarrier xcd_barrier_post(unsigned* bar, volatile LAS unsigned* st) {
    XcdBarrier b; b.bar = bar; b.x = xb_xcc_id(); b.st = st;
    if (threadIdx.x == 0) (void)xb_add(&bar[XB_XCNT(b.x)], 1u);
    return b;
}
__device__ __forceinline__ void xcd_barrier_complete(unsigned* bar, unsigned x, unsigned& nloc, unsigned& nx) {
    const unsigned G = gridDim.x * gridDim.y * gridDim.z;
    unsigned sum, cnt, mine, sp = 0u;
    for (;;) {
        sum = 0u; cnt = 0u; mine = 0u;
#pragma unroll
        for (unsigned j = 0; j < 16; ++j) { const unsigned c = xb_ld(&bar[XB_XCNT(j)]); sum += c; cnt += (c > 0u) ? 1u : 0u; mine = (j == x) ? c : mine; }
        if (sum == G) break;
        __builtin_amdgcn_s_sleep(1);
        if ((++sp & 255u) == 0u) { if (xb_ld(&bar[XB_TMO])) break; if (sp > XB_SPIN_CAP) { atomicAdd(&bar[XB_TMO], 1u); break; } }
    }
    nloc = mine > 0u ? mine : 1u; nx = cnt > 0u ? cnt : 1u;
}
__device__ __forceinline__ void xcd_barrier(const XcdBarrier& b) {
    asm volatile("s_waitcnt vmcnt(0)" ::: "memory");
    __syncthreads();
    if (threadIdx.x == 0) {
        unsigned* bar = b.bar;
        __builtin_amdgcn_s_waitcnt(0);
        unsigned nloc = b.st[0], nx = b.st[1];
        if (nloc == 0u) { xcd_barrier_complete(bar, b.x, nloc, nx); b.st[0] = nloc; b.st[1] = nx; }
        const unsigned old = xb_add(&bar[XB_XSUB(b.x)], 1u);
        const unsigned gen = old / nloc;
        if (old + 1u == (gen + 1u) * nloc) {
            __builtin_amdgcn_fence(__ATOMIC_RELEASE, "agent");
            asm volatile("s_waitcnt vmcnt(0)" ::: "memory");
            const unsigned og = xb_add(&bar[XB_TOP], 1u);
            const unsigned tg = og / nx;
            if (og + 1u == (tg + 1u) * nx) xb_add(&bar[XB_TOPGEN], 1u);
            else XB_SPIN(xb_ld(&bar[XB_TOPGEN]) == tg, bar);
            __builtin_amdgcn_fence(__ATOMIC_ACQUIRE, "agent");
            xb_add(&bar[XB_XGEN(b.x)], 1u);
            asm volatile("s_waitcnt vmcnt(0)" ::: "memory");
        } else {
            XB_SPIN(xb_ld(&bar[XB_XGEN(b.x)]) == gen, bar);
            __builtin_amdgcn_fence(__ATOMIC_ACQUIRE, "agent");
            asm volatile("s_waitcnt vmcnt(0)" ::: "memory");
        }
    }
    __syncthreads();
}

__global__ void __launch_bounds__(NWAVES * 64, 2) mk_fwd(Args a) {
    extern __shared__ __attribute__((aligned(16))) unsigned char lds[];
    cg::grid_group grid = cg::this_grid();
    LAS unsigned char* ldsL = (LAS unsigned char*)lds;
    const int tid = threadIdx.x, lane = tid & 63, wave = __builtin_amdgcn_readfirstlane(tid >> 6);
    const int G = gridDim.x, bx = blockIdx.x;
    const int vcu = (G % 8 == 0) ? (bx % 8) * (G / 8) + bx / 8 : bx;
    const int gw = bx * NWAVES + wave, ngw = G * NWAVES;
    unsigned char* ws = a.ws;
    bf16_t* WIN = (bf16_t*)(ws + WS_WIN); bf16_t* WOUT = (bf16_t*)(ws + WS_WOUT); bf16_t* WUP = (bf16_t*)(ws + WS_WUP); bf16_t* WDN = (bf16_t*)(ws + WS_WDN);
    bf16_t* WMKV = (bf16_t*)(ws + WS_WMKV); bf16_t* MEMB = (bf16_t*)(ws + WS_MEMB); bf16_t* MEMKV = (bf16_t*)(ws + WS_MEMKV);
    bf16_t* XB = (bf16_t*)(ws + WS_XB); bf16_t* HB = (bf16_t*)(ws + WS_H); bf16_t* PROJ = (bf16_t*)(ws + WS_PROJ); bf16_t* MIXED = (bf16_t*)(ws + WS_MIXED);
    float* X = a.out;
    volatile LAS unsigned* MISC = (volatile LAS unsigned*)(ldsL + LDS_MISC);
    if (tid < 16) MISC[tid] = 0u;
    __syncthreads();
    if (blockIdx.x == 0) { for (int i = tid; i < (int)(CTL_BYTES / 4); i += NWAVES * 64) ((unsigned*)(ws + WS_CTL))[i] = 0u; }
    float* STA = (float*)(ws + WS_STA); float* STB = (float*)(ws + WS_STB);
    float* PU_IN = (float*)(ws + WS_PUV); float* PV_IN = PU_IN + DEPTH * 16 * INW; float* PU_UP = PV_IN + DEPTH * 16 * INW; float* PV_UP = PU_UP + DEPTH * 16 * FF;
    float* U_IN = (float*)(ws + WS_UV); float* V_IN = U_IN + DEPTH * INW; float* U_UP = V_IN + DEPTH * INW; float* V_UP = U_UP + DEPTH * FF;
#ifdef PROBE_T
    unsigned long long tacc = 0, tst = 0;
#define TB(id) do { if (PROBE_T == (id)) tst = __builtin_amdgcn_s_memrealtime(); } while (0)
#define TE(id) do { if (PROBE_T == (id)) tacc += __builtin_amdgcn_s_memrealtime() - tst; } while (0)
#else
#define TB(id) do {} while (0)
#define TE(id) do {} while (0)
#endif

    {
        LAS float* scr = (LAS float*)(ldsL + wave * 16384);
        constexpr int I_IN = (DM / 64) * (INW / 32), I_OUT = (DM / 64) * (DM / 32), I_UP = (DM / 64) * (FF / 32), I_DN = (FF / 64) * (DM / 32), I_MKV = (DM / 64) * (512 / 32);
        constexpr int I_LAYER = I_IN + I_OUT + I_UP + I_DN + I_MKV;
        for (int it = gw; it < DEPTH * I_LAYER; it += ngw) {
            const int l = it / I_LAYER; int r = it % I_LAYER;
            if (r < I_IN) { transpose_item(a.w_in + (size_t)l * DM * INW, DM, INW, WIN + (size_t)l * INW * DM, 0, scr, r, lane,
                                           l ? a.ln2_g + (l - 1) * DM : a.emb_g, l ? a.ln2_b + (l - 1) * DM : a.emb_b, PU_IN + (size_t)l * 16 * INW, PV_IN + (size_t)l * 16 * INW); continue; } r -= I_IN;
            if (r < I_OUT) { transpose_item(a.w_out + (size_t)l * DM * DM, DM, DM, WOUT + (size_t)l * DM * DM, 0, scr, r, lane, nullptr, nullptr, nullptr, nullptr); continue; } r -= I_OUT;
            if (r < I_UP) { transpose_item(a.w_up + (size_t)l * DM * FF, DM, FF, WUP + (size_t)l * FF * DM, 0, scr, r, lane,
                                           a.ln1_g + l * DM, a.ln1_b + l * DM, PU_UP + (size_t)l * 16 * FF, PV_UP + (size_t)l * 16 * FF); continue; } r -= I_UP;
            if (r < I_DN) { transpose_item(a.w_down + (size_t)l * FF * DM, FF, DM, WDN + (size_t)l * DM * FF, 0, scr, r, lane, nullptr, nullptr, nullptr, nullptr); continue; } r -= I_DN;
            transpose_item(a.w_mkv + (size_t)l * DM * 512, DM, 512, WMKV, l * 512, scr, r, lane, nullptr, nullptr, nullptr, nullptr);
        }
        for (size_t i = (size_t)bx * 512 + tid; i < (size_t)MMEM * DM / 8; i += (size_t)G * 512) {
            const f32x4 v0 = ((const f32x4*)a.mem)[2 * i], v1 = ((const f32x4*)a.mem)[2 * i + 1];
            u32x4 o; o.x = cvt_pk_bf16(v0.x, v0.y); o.y = cvt_pk_bf16(v0.z, v0.w); o.z = cvt_pk_bf16(v1.x, v1.y); o.w = cvt_pk_bf16(v1.z, v1.w);
            ((u32x4*)MEMB)[i] = o;
        }
        copy_stats_phase(a.x, XB, STA, gw, ngw);
    }
    grid.sync();
    const XcdBarrier bar = xcd_barrier_post((unsigned*)(ws + WS_CTL), MISC);
    for (int i = bx * 512 + tid; i < DEPTH * (INW + FF); i += G * 512) {
        if (i < DEPTH * INW) { const int l = i / INW, n = i % INW; float su = 0.f, sv = 0.f;
            for (int kb = 0; kb < 16; ++kb) { su += PU_IN[((size_t)l * 16 + kb) * INW + n]; sv += PV_IN[((size_t)l * 16 + kb) * INW + n]; }
            U_IN[i] = su; V_IN[i] = sv + a.b_in[i]; }
        else { const int j = i - DEPTH * INW, l = j / FF, n = j % FF; float su = 0.f, sv = 0.f;
            for (int kb = 0; kb < 16; ++kb) { su += PU_UP[((size_t)l * 16 + kb) * FF + n]; sv += PV_UP[((size_t)l * 16 + kb) * FF + n]; }
            U_UP[j] = su; V_UP[j] = sv; }
    }
    {
        pg8::Gemm g{MEMB, WMKV, MMEM, DEPTH * 512, DM}; pg8::StaticOrder S; S.init(MMEM, DEPTH * 512, G, bx);
        pg8::EpiStore<0> E{MEMKV, DEPTH * 512, nullptr, nullptr, nullptr};
#ifndef SKIP_GMKV
        pg8::gemm_phase<pg8::EpiStore<0>, pg8::StaticOrder>(ldsL, g, S, E);
#endif
    }
    grid.sync();

    for (int l = 0; l < DEPTH; ++l) {
        {
            pg8::Gemm g{XB, WIN + (size_t)l * INW * DM, MTOK, INW, DM}; pg8::StaticOrder S; S.init(MTOK, INW, G, bx);
            pg8::EpiStore<1> E{PROJ, INW, STA, U_IN + l * INW, V_IN + l * INW};
            TB(5);
#ifndef SKIP_GPROJ
            pg8::gemm_phase<pg8::EpiStore<1>, pg8::StaticOrder>(ldsL, g, S, E);
#ifdef DUP_PROJ
            pg8::gemm_phase<pg8::EpiStore<1>, pg8::StaticOrder>(ldsL, g, S, E);
#endif
#endif
            TE(5);
        }
        TB(4); xcd_barrier(bar); TE(4);
#ifdef DUP_SYNC
        xcd_barrier(bar); xcd_barrier(bar); xcd_barrier(bar); xcd_barrier(bar);
#endif
#if defined(STOP_AT) && STOP_AT == 1
        return;
#endif
        {
#ifdef ATT2
            LAS float* tabs = (LAS float*)(ldsL + att::L2_TAB);
#else
            LAS float* tabs = (LAS float*)(ldsL + att::L_TAB);
#endif
            const int tidp = opaque_tid(), lanep = tidp & 63;
            for (int i = tidp; i < 4 * att::TABN; i += 512) { const int h = i / att::TABN, rel = i % att::TABN - att::TABC; tabs[i] = a.rel_bias[t5_bucket(rel) * 4 + h] * LOG2E; }
            float lam;
            { const float d1 = wave_sum(a.lq1[l * 64 + lanep] * a.lk1[l * 64 + lanep]), d2 = wave_sum(a.lq2[l * 64 + lanep] * a.lk2[l * 64 + lanep]);
              lam = expf(d1) - expf(d2) + a.lam_init[l]; }
            const float oscale = 1.f - a.lam_init[l];
            __syncthreads();
            TB(1);
#ifndef SKIP_DIFF
#ifdef DUP_DIFF
            for (int rep = 0; rep < 2; ++rep)
#endif
#ifdef ATT2
            for (int id = vcu; id < BATCH * 4 * 16; id += G) {
                const int bh = id >> 4, qb = id & 15, b = bh >> 2, h = bh & 3;
                const size_t row0 = (size_t)b * SEQ + qb * 256;
                att::attn_unit2<false>(PROJ + row0 * INW + 512 + h * 128, INW, PROJ + (size_t)b * SEQ * INW + 1024 + h * 128, PROJ + (size_t)b * SEQ * INW + 1536 + h * 128, INW,
                                       MIXED + row0 * DM + 256 + h * 128, qb * 256, tabs + h * att::TABN, lam, oscale, a.diff_g + l * 128, (char*)lds);
            }
#else
            for (int id = vcu; id < BATCH * 4 * 32; id += G) {
                const int bh = id >> 5, qb = id & 31, b = bh >> 2, h = bh & 3;
                const size_t row0 = (size_t)b * SEQ + qb * 128;
                att::attn_unit<false>(PROJ + row0 * INW + 512 + h * 128, INW, PROJ + (size_t)b * SEQ * INW + 1024 + h * 128, PROJ + (size_t)b * SEQ * INW + 1536 + h * 128, INW,
                                      MIXED + row0 * DM + 256 + h * 128, qb * 128, tabs + h * att::TABN, lam, oscale, a.diff_g + l * 128, (char*)lds);
            }
#endif
#endif
            TE(1);
            __syncthreads();
            TB(2);
#ifndef SKIP_MEMATT
#ifdef ATT2
            for (int id = vcu; id < BATCH * 2 * 16; id += G) {
                const int bp = id >> 4, qb = id & 15, b = bp >> 1, hp = bp & 1;
                const size_t row0 = (size_t)b * SEQ + qb * 256;
                att::attn_unit2<true>(PROJ + row0 * INW + 2048 + hp * 128, INW, MEMKV + (size_t)b * MEML * 2048 + l * 512 + hp * 128, MEMKV + (size_t)b * MEML * 2048 + l * 512 + 256 + hp * 128, 2048,
                                      MIXED + row0 * DM + 768 + hp * 128, 0, tabs, 0.f, 0.f, nullptr, (char*)lds);
            }
#else
            for (int id = vcu; id < BATCH * 2 * 32; id += G) {
                const int bp = id >> 5, qb = id & 31, b = bp >> 1, hp = bp & 1;
                const size_t row0 = (size_t)b * SEQ + qb * 128;
                att::attn_unit<true>(PROJ + row0 * INW + 2048 + hp * 128, INW, MEMKV + (size_t)b * MEML * 2048 + l * 512 + hp * 128, MEMKV + (size_t)b * MEML * 2048 + l * 512 + 256 + hp * 128, 2048,
                                     MIXED + row0 * DM + 768 + hp * 128, 0, tabs, 0.f, 0.f, nullptr, (char*)lds);
            }
#ifdef DUP_MISC
            __syncthreads();
            for (int id = vcu; id < BATCH * 2 * 32; id += G) {
                const int bp = id >> 5, qb = id & 31, b = bp >> 1, hp = bp & 1;
                const size_t row0 = (size_t)b * SEQ + qb * 128;
                att::attn_unit<true>(PROJ + row0 * INW + 2048 + hp * 128, INW, MEMKV + (size_t)b * MEML * 2048 + l * 512 + hp * 128, MEMKV + (size_t)b * MEML * 2048 + l * 512 + 256 + hp * 128, 2048,
                                     MIXED + row0 * DM + 768 + hp * 128, 0, tabs, 0.f, 0.f, nullptr, (char*)lds);
            }
#endif
#endif
#endif
            TE(2);
            __syncthreads();
            TB(3);
#ifndef SKIP_CONV
            for (int id = bx; id < MTOK / 32; id += G)
                conv_unit(PROJ, MIXED, a.conv_w + l * CONVW * CONVC, a.conv_b + l * CONVC, a.conv_ln_g + l * CONVC, a.conv_ln_b + l * CONVC, id, (LAS float*)ldsL);
#ifdef DUP_MISC
            for (int id = bx; id < MTOK / 32; id += G)
                conv_unit(PROJ, MIXED, a.conv_w + l * CONVW * CONVC, a.conv_b + l * CONVC, a.conv_ln_g + l * CONVC, a.conv_ln_b + l * CONVC, id, (LAS float*)ldsL);
#endif
#endif
            TE(3);
        }
        TB(4); xcd_barrier(bar); TE(4);
#ifdef DUP_SYNC
        xcd_barrier(bar); xcd_barrier(bar); xcd_barrier(bar); xcd_barrier(bar);
#endif
#if defined(STOP_AT) && STOP_AT == 2
        return;
#endif
        {
            pg8::Gemm g{MIXED, WOUT + (size_t)l * DM * DM, MTOK, DM, DM}; pg8::StaticOrder S; S.init(MTOK, DM, G, bx);
            pg8::EpiResid E{XB, STA, l ? a.ln2_g + (l - 1) * DM : a.emb_g, l ? a.ln2_b + (l - 1) * DM : a.emb_b, STB, a.b_out + l * DM};
            TB(6);
#ifndef SKIP_GOUT
            pg8::gemm_phase<pg8::EpiResid, pg8::StaticOrder>(ldsL, g, S, E);
#endif
            TE(6);
        }
        TB(4); xcd_barrier(bar); TE(4);
#ifdef DUP_SYNC
        xcd_barrier(bar); xcd_barrier(bar); xcd_barrier(bar); xcd_barrier(bar);
#endif
#if defined(STOP_AT) && STOP_AT == 3
        return;
#endif
        {
            pg8::Gemm g{XB, WUP + (size_t)l * FF * DM, MTOK, FF, DM}; pg8::StaticOrder S; S.init(MTOK, FF, G, bx);
            pg8::EpiStore<2> E{HB, FF, STB, U_UP + l * FF, V_UP + l * FF};
            TB(7);
#ifndef SKIP_GUP
            pg8::gemm_phase<pg8::EpiStore<2>, pg8::StaticOrder>(ldsL, g, S, E);
#ifdef DUP_UP
            pg8::gemm_phase<pg8::EpiStore<2>, pg8::StaticOrder>(ldsL, g, S, E);
#endif
#endif
            TE(7);
        }
        TB(4); xcd_barrier(bar); TE(4);
#ifdef DUP_SYNC
        xcd_barrier(bar); xcd_barrier(bar); xcd_barrier(bar); xcd_barrier(bar);
#endif
        {
            pg8::Gemm g{HB, WDN + (size_t)l * DM * FF, MTOK, DM, FF}; pg8::StaticOrder S; S.init(MTOK, DM, G, bx);
            pg8::EpiResid E{XB, STB, a.ln1_g + l * DM, a.ln1_b + l * DM, STA, nullptr};
            TB(8);
#ifndef SKIP_GDOWN
            pg8::gemm_phase<pg8::EpiResid, pg8::StaticOrder>(ldsL, g, S, E);
#endif
            TE(8);
        }
        TB(4); xcd_barrier(bar); TE(4);
#ifdef DUP_SYNC
        xcd_barrier(bar); xcd_barrier(bar); xcd_barrier(bar); xcd_barrier(bar);
#endif
    }
    ln_final_phase(XB, STA, a.ln2_g + (DEPTH - 1) * DM, a.ln2_b + (DEPTH - 1) * DM, X, gw, ngw);
#ifdef PROBE_T
    if (bx == 0 && tid == 0) X[0] = (float)tacc * 0.01f;
#endif
}

extern "C" void kernel_launch(void* const* d_in, const int* in_sizes, int n_in, void* d_out, int out_size, void* d_ws, size_t ws_size, hipStream_t stream) {
    static int grid = 0;
    if (grid == 0) {
        if (n_in != 25 || in_sizes[0] != MTOK * DM || out_size != MTOK * DM || ws_size < WS_END) {
            fprintf(stderr, "kernel_launch: unexpected shapes: n_in %d in0 %d out %d ws %zu (need >= %zu)\n", n_in, n_in > 0 ? in_sizes[0] : -1, out_size, ws_size, (size_t)WS_END); grid = -1; return; }
        int dev = 0, cus = 0, per_cu = 0;
        if (hipGetDevice(&dev) != hipSuccess || hipDeviceGetAttribute(&cus, hipDeviceAttributeMultiprocessorCount, dev) != hipSuccess) { fprintf(stderr, "kernel_launch: device query failed\n"); grid = -1; return; }
        if (hipFuncSetAttribute((const void*)mk_fwd, hipFuncAttributeMaxDynamicSharedMemorySize, LDS_BYTES) != hipSuccess) { fprintf(stderr, "kernel_launch: hipFuncSetAttribute failed\n"); grid = -1; return; }
        if (hipOccupancyMaxActiveBlocksPerMultiprocessor(&per_cu, (const void*)mk_fwd, NWAVES * 64, LDS_BYTES) != hipSuccess || per_cu < 1) { fprintf(stderr, "kernel_launch: occupancy query says %d\n", per_cu); per_cu = 1; }
        (void)hipGetLastError();
        grid = cus * per_cu;
    }
    if (grid < 0) return;
    Args a{};
    const float** f = (const float**)&a;
    for (int i = 0; i < 25; ++i) f[i] = (const float*)d_in[i];
    a.out = (float*)d_out; a.ws = (unsigned char*)d_ws;
    for (int l = 0; l < 4; ++l) a.lam_init[l] = (float)(0.8 - 0.6 * std::exp(-0.3 * (double)l));
    void* args[] = {&a};
    hipError_t e = hipLaunchCooperativeKernel((const void*)mk_fwd, dim3(grid), dim3(NWAVES * 64), args, LDS_BYTES, stream);
    if (e != hipSuccess) { fprintf(stderr, "kernel_launch: cooperative launch failed: %s (grid %d)\n", hipGetErrorString(e), grid); (void)hipGetLastError(); (void)hipMemsetAsync(d_out, 0, (size_t)out_size * 4, stream); }
}
```

```cpp
#define ATT2
#include <hip/hip_runtime.h>
#include <hip/hip_cooperative_groups.h>
#include <cstdio>
#include <cstdint>
#include <cmath>
namespace cg = cooperative_groups;

#define LAS __attribute__((address_space(3)))
typedef unsigned short bf16_t;
typedef short bf16x8 __attribute__((ext_vector_type(8)));
typedef short s16x4 __attribute__((ext_vector_type(4)));
typedef float f32x4 __attribute__((ext_vector_type(4)));
typedef float f32x2 __attribute__((ext_vector_type(2)));
typedef float f32x16 __attribute__((ext_vector_type(16)));
typedef unsigned u32x4 __attribute__((ext_vector_type(4)));
typedef unsigned u32x2 __attribute__((ext_vector_type(2)));

constexpr int BATCH = 16, SEQ = 4096, DM = 1024, DEPTH = 4, MEML = 256, INW = 2304, FF = 4096;
constexpr int MTOK = BATCH * SEQ;
constexpr int MMEM = BATCH * MEML;
constexpr int CONVC = 256, CONVW = 31;
constexpr float ALPHA = 1.6817928305074290f;
constexpr float LN_EPS = 1e-5f;
constexpr float LOG2E = 1.4426950408889634f;
constexpr float QSCALE = 0.125f * LOG2E;
constexpr int NWAVES = 8;

constexpr size_t MiB = 1u << 20;
constexpr size_t WS_WIN = 0;
constexpr size_t WS_WOUT = 18 * MiB;
constexpr size_t WS_WUP = 26 * MiB;
constexpr size_t WS_WDN = 58 * MiB;
constexpr size_t WS_WMKV = 90 * MiB;
constexpr size_t WS_MEMB = 94 * MiB;
constexpr size_t WS_MEMKV = 102 * MiB;
constexpr size_t WS_XB = 120 * MiB;
constexpr size_t WS_H = 248 * MiB;
constexpr size_t WS_PROJ = 248 * MiB;
constexpr size_t WS_MIXED = 536 * MiB;
constexpr size_t WS_STA = 760 * MiB;
constexpr size_t WS_STB = 762 * MiB;
constexpr size_t WS_PUV = 764 * MiB;
constexpr size_t WS_UV = 768 * MiB;
constexpr size_t WS_CTL = 769 * MiB;
constexpr size_t CTL_BYTES = 16384;
constexpr size_t WS_END = 770 * MiB;

constexpr int LDS_MISC = 155648;
constexpr int LDS_BYTES = 155648 + 64;

__device__ __forceinline__ unsigned cvt_pk_bf16(float lo, float hi) { unsigned r; asm volatile("v_cvt_pk_bf16_f32 %0, %1, %2" : "=v"(r) : "v"(lo), "v"(hi)); return r; }
__device__ __forceinline__ float bf2f(unsigned short b) { return __uint_as_float(((unsigned)b) << 16); }
__device__ __forceinline__ int opaque_tid() { int t = threadIdx.x; asm volatile("" : "+v"(t)); return t; }
__device__ __forceinline__ float shfl_xor_f(float v, int o) { const int ln = opaque_tid() & 63; return __int_as_float(__builtin_amdgcn_ds_bpermute((ln ^ o) << 2, __float_as_int(v))); }
__device__ __forceinline__ float wave_sum(float v) {
#pragma unroll
    for (int o = 1; o < 64; o <<= 1) v += shfl_xor_f(v, o);
    return v;
}

namespace pg8 {
constexpr int BM = 256, BK = 64, HALF = 128, HTB = HALF * BK * 2, STAGE_BYTES = 8 * HTB, NXCD = 8, WGM = 8;
__host__ __device__ __forceinline__ int lds_byte(int r, int c) { const int st = (r >> 4) * 2 + (c >> 5), rr = r & 15, cc = c & 31, ob = rr * 64 + cc * 2; return st * 1024 + (ob ^ (((ob >> 9) & 1) << 5)); }
__host__ __device__ __forceinline__ void stage_rc(int b, int& R, int& C) { const int st = b / 1024, sb = b % 1024, swz = sb ^ (((sb >> 9) & 1) << 5); R = (st >> 1) * 16 + swz / 64; C = (st & 1) * 32 + (swz % 64) / 2; }
__host__ __device__ __forceinline__ int perm32(int rho) { const int n = rho >> 4, i = rho & 15; return 8 * (i >> 2) + 4 * n + (i & 3); }

struct Unit { int pm, pn; };
struct Gemm { const bf16_t* A; const bf16_t* Bt; int M, N, K; };

struct StaticOrder {
    int nM, nN, nwg, G, c;
    __host__ __device__ void init(int M, int N, int G_, int c_) { nM = M / BM; nN = N / BM; nwg = nM * nN; G = G_; c = c_; }
    __host__ __device__ bool next(int i, Unit& u) const {
        const long L = (long)i * G + c; if (L >= nwg) return false;
        int wgid = (int)L; { const int q = nwg / NXCD, r = nwg % NXCD, xcd = wgid % NXCD, off = wgid / NXCD; wgid = (xcd < r ? xcd * (q + 1) : r * (q + 1) + (xcd - r) * q) + off; }
        const int nig = WGM * nN, gid = wgid / nig, fm = gid * WGM, gsz = (nM - fm) < WGM ? (nM - fm) : WGM;
        u.pm = fm + ((wgid % nig) % gsz); u.pn = (wgid % nig) / gsz; return true;
    }
};

__device__ __forceinline__ void row_mean_rstd(const float* st, int row, float& mu, float& rs) {
    const f32x4 s0 = *(const f32x4*)(st + (size_t)row * 8), s1 = *(const f32x4*)(st + (size_t)row * 8 + 4);
    const float S = (s0.x + s0.z) + (s1.x + s1.z), Q = (s0.y + s0.w) + (s1.y + s1.w);
    mu = S * (1.f / DM); rs = __builtin_amdgcn_rsqf(fmaxf(Q * (1.f / DM) - mu * mu, 0.f) + LN_EPS);
}
template <int MODE> struct EpiStore {
    static constexpr bool PERM = true;
    bf16_t* O; int ldc; const float* st; const float* U; const float* V;
    __device__ __forceinline__ void operator()(f32x4 (&acc)[2][2][4][2], const Unit& u, int wr, int wc, int fr, int fq, LAS unsigned char* lds, int tid) const {
        const int row0 = u.pm * BM + wr * 64 + fr; const int col0 = u.pn * BM + wc * 32 + 8 * fq;
        float sc = 1.f; if (MODE == 1) { if (u.pn == 2 || u.pn == 3 || u.pn == 8) sc = QSCALE; }
        f32x4 uu[2][2], vv[2][2];
#pragma unroll
        for (int bj = 0; bj < 2; ++bj)
#pragma unroll
            for (int n = 0; n < 2; ++n) { uu[bj][n] = (MODE != 0) ? *(const f32x4*)(U + col0 + bj * HALF + 4 * n) : (f32x4){0.f, 0.f, 0.f, 0.f}; vv[bj][n] = (MODE != 0) ? *(const f32x4*)(V + col0 + bj * HALF + 4 * n) : (f32x4){0.f, 0.f, 0.f, 0.f}; }
#pragma unroll
        for (int ai = 0; ai < 2; ++ai)
#pragma unroll
            for (int m = 0; m < 4; ++m) { const int row = row0 + ai * HALF + m * 16; bf16_t* rowp = O + (size_t)row * ldc + col0;
                float mu = 0.f, rs = 1.f; if (MODE != 0) row_mean_rstd(st, row, mu, rs);
#pragma unroll
                for (int bj = 0; bj < 2; ++bj) { f32x4 v0 = acc[ai][bj][m][0], v1 = acc[ai][bj][m][1];
                    if (MODE != 0) { v0 = (v0 - uu[bj][0] * mu) * rs + vv[bj][0]; v1 = (v1 - uu[bj][1] * mu) * rs + vv[bj][1]; }
                    if (MODE == 2) { v0 = __builtin_elementwise_max(v0, (f32x4){0.f, 0.f, 0.f, 0.f}); v1 = __builtin_elementwise_max(v1, (f32x4){0.f, 0.f, 0.f, 0.f}); v0 = v0 * v0; v1 = v1 * v1; }
                    if (MODE == 1) { v0 = v0 * sc; v1 = v1 * sc; }
                    u32x4 w; w.x = cvt_pk_bf16(v0[0], v0[1]); w.y = cvt_pk_bf16(v0[2], v0[3]); w.z = cvt_pk_bf16(v1[0], v1[1]); w.w = cvt_pk_bf16(v1[2], v1[3]);
                    if (MODE == 2) __builtin_nontemporal_store(w, (u32x4*)(rowp + bj * HALF)); else *(u32x4*)(rowp + bj * HALF) = w; } }
    }
};
struct EpiResid {
    static constexpr bool PERM = true;
    bf16_t* XB; const float* sp; const float* gp; const float* bp; float* sn; const float* bias;
    __device__ __forceinline__ void operator()(f32x4 (&acc)[2][2][4][2], const Unit& u, int wr, int wc, int fr, int fq, LAS unsigned char* lds, int tid) const {
        const int col0 = u.pn * BM + wc * 32 + 8 * fq;
        LAS f32x2* P = (LAS f32x2*)(lds + STAGE_BYTES);
        f32x4 gg[2][2], bb[2][2];
#pragma unroll
        for (int bj = 0; bj < 2; ++bj)
#pragma unroll
            for (int n = 0; n < 2; ++n) { gg[bj][n] = *(const f32x4*)(gp + col0 + bj * HALF + n * 4) * ALPHA;
                bb[bj][n] = *(const f32x4*)(bp + col0 + bj * HALF + n * 4) * ALPHA; if (bias) bb[bj][n] = bb[bj][n] + *(const f32x4*)(bias + col0 + bj * HALF + n * 4); }
#pragma unroll
        for (int ai = 0; ai < 2; ++ai)
#pragma unroll
            for (int m = 0; m < 4; ++m) { const int rloc = ai * HALF + wr * 64 + m * 16 + fr, row = u.pm * BM + rloc;
                float mu, rs; row_mean_rstd(sp, row, mu, rs);
                bf16_t* rb = XB + (size_t)row * DM + col0; float s = 0.f, q = 0.f;
#pragma unroll
                for (int bj = 0; bj < 2; ++bj) { const u32x4 xw = *(const u32x4*)(rb + bj * HALF);
                    const f32x4 x0 = {__uint_as_float(xw.x << 16), __uint_as_float(xw.x & 0xffff0000u), __uint_as_float(xw.y << 16), __uint_as_float(xw.y & 0xffff0000u)};
                    const f32x4 x1 = {__uint_as_float(xw.z << 16), __uint_as_float(xw.z & 0xffff0000u), __uint_as_float(xw.w << 16), __uint_as_float(xw.w & 0xffff0000u)};
                    const f32x4 t0 = (x0 - mu) * rs * gg[bj][0] + bb[bj][0] + acc[ai][bj][m][0];
                    const f32x4 t1 = (x1 - mu) * rs * gg[bj][1] + bb[bj][1] + acc[ai][bj][m][1];
                    u32x4 w; w.x = cvt_pk_bf16(t0.x, t0.y); w.y = cvt_pk_bf16(t0.z, t0.w); w.z = cvt_pk_bf16(t1.x, t1.y); w.w = cvt_pk_bf16(t1.z, t1.w);
                    __builtin_nontemporal_store(w, (u32x4*)(rb + bj * HALF));
                    s += ((t0.x + t0.y) + (t0.z + t0.w)) + ((t1.x + t1.y) + (t1.z + t1.w));
                    q += ((t0.x * t0.x + t0.y * t0.y) + (t0.z * t0.z + t0.w * t0.w)) + ((t1.x * t1.x + t1.y * t1.y) + (t1.z * t1.z + t1.w * t1.w)); }
                s += shfl_xor_f(s, 16); q += shfl_xor_f(q, 16); s += shfl_xor_f(s, 32); q += shfl_xor_f(q, 32);
                if (fq == 0) P[rloc * 4 + wc] = (f32x2){s, q};
                if (m & 1) asm volatile("" ::: "memory"); }
        asm volatile("s_waitcnt lgkmcnt(0)" ::: "memory"); __builtin_amdgcn_s_barrier(); asm volatile("" ::: "memory");
        if (tid < 256) { const f32x2 p0 = P[tid * 4 + 0], p1 = P[tid * 4 + 1], p2 = P[tid * 4 + 2], p3 = P[tid * 4 + 3];
            *(f32x2*)(sn + (size_t)(u.pm * BM + tid) * 8 + u.pn * 2) = (f32x2){(p0.x + p1.x) + (p2.x + p3.x), (p0.y + p1.y) + (p2.y + p3.y)}; }
    }
};

template <class Epi, class Sched>
__device__ __forceinline__ void gemm_phase(LAS unsigned char* lds, const Gemm g, const Sched& S, const Epi& E) {
    const int tid = opaque_tid(), wid = __builtin_amdgcn_readfirstlane(tid >> 6), lane = tid & 63, wr = wid >> 2, wc = wid & 3, fr = lane & 15, fq = lane >> 4;
    const int K = g.K, nt = K / BK;
    unsigned voffA[2], voffB[2];
#pragma unroll
    for (int i = 0; i < 2; ++i) { int R, C; stage_rc(tid * 16 + i * 8192, R, C); const int Rb = Epi::PERM ? ((R & ~31) + perm32(R & 31)) : R;
        voffA[i] = (unsigned)(R * K + C) * 2u; voffB[i] = (unsigned)(Rb * K + C) * 2u; }
    const size_t kstep = (size_t)(BK * 2);
    const size_t hstep = (size_t)HALF * K * 2;
    const size_t tstep = 2 * hstep;
    const unsigned ldsw = (unsigned)wid * 1024u;
    const int aoff = lds_byte(wr * 64 + fr, fq * 8), boff = lds_byte(wc * 32 + fr, fq * 8);
#define PG8_SA(b, h) (((b) * 2 + (h)) * HTB)
#define PG8_SB(b, h) ((4 + (b) * 2 + (h)) * HTB)
#define PG8_STAGE(bufoff, gbase, voff) do { _Pragma("unroll") for (int _i = 0; _i < 2; ++_i) \
        __builtin_amdgcn_global_load_lds((const unsigned*)((const char*)(gbase) + (voff)[_i]), (LAS unsigned*)(lds + (bufoff) + ldsw + _i * 8192), 16, 0, 0); } while (0)
#define PG8_LDA(dst, b, h) do { _Pragma("unroll") for (int m = 0; m < 4; ++m) _Pragma("unroll") for (int k = 0; k < 2; ++k) dst[m][k] = *(const LAS bf16x8*)(lds + PG8_SA(b, h) + aoff + m * 2048 + k * 1024); } while (0)
#define PG8_LDB(dst, b, h) do { _Pragma("unroll") for (int n = 0; n < 2; ++n) _Pragma("unroll") for (int k = 0; k < 2; ++k) dst[n][k] = *(const LAS bf16x8*)(lds + PG8_SB(b, h) + boff + n * 2048 + k * 1024); } while (0)
#define PG8_MMA(ai, bj, At, Bt) do { __builtin_amdgcn_s_setprio(1); _Pragma("unroll") for (int m = 0; m < 4; ++m) _Pragma("unroll") for (int n = 0; n < 2; ++n) _Pragma("unroll") for (int k = 0; k < 2; ++k) \
        acc[ai][bj][m][n] = __builtin_amdgcn_mfma_f32_16x16x32_bf16(Bt[n][k], At[m][k], acc[ai][bj][m][n], 0, 0, 0); __builtin_amdgcn_s_setprio(0); } while (0)
#define PG8_WAIT_V(n) asm volatile("s_waitcnt vmcnt(" #n ")" ::: "memory")
#define PG8_WAIT_L(n) asm volatile("s_waitcnt lgkmcnt(" #n ")" ::: "memory")
#define PG8_BAR __builtin_amdgcn_s_barrier()
#define PG8_SCHED __builtin_amdgcn_sched_barrier(0)
    Unit cur, nxt; int ui = 0;
    if (!S.next(0, cur)) return;
    f32x4 acc[2][2][4][2];
#pragma unroll
    for (int a = 0; a < 2; ++a)
#pragma unroll
        for (int b = 0; b < 2; ++b)
#pragma unroll
            for (int m = 0; m < 4; ++m)
#pragma unroll
                for (int n = 0; n < 2; ++n) acc[a][b][m][n] = (f32x4){0.f, 0.f, 0.f, 0.f};
    bf16x8 At[4][2], B0[2][2], B1[2][2];
    const char* cA = (const char*)g.A + (size_t)cur.pm * tstep; const char* cB = (const char*)g.Bt + (size_t)cur.pn * tstep;
    PG8_STAGE(PG8_SB(0, 0), cB, voffB); PG8_STAGE(PG8_SB(0, 1), cB + hstep, voffB); PG8_STAGE(PG8_SA(0, 0), cA, voffA); PG8_STAGE(PG8_SA(0, 1), cA + hstep, voffA);
    if (wr == 1) PG8_BAR;
    PG8_WAIT_V(2); PG8_BAR;
    PG8_STAGE(PG8_SB(1, 0), cB + kstep, voffB); PG8_STAGE(PG8_SA(1, 0), cA + kstep, voffA); PG8_STAGE(PG8_SB(1, 1), cB + hstep + kstep, voffB);
    PG8_WAIT_V(6); PG8_BAR;
    for (;;) {
        const bool has_next = S.next(ui + 1, nxt);
        const char* nA = has_next ? (const char*)g.A + (size_t)nxt.pm * tstep : cA; const char* nB = has_next ? (const char*)g.Bt + (size_t)nxt.pn * tstep : cB;
        for (int t = 0; t < nt; t += 2) {
            const bool last = (t == nt - 2);
            const char* a1 = cA + (size_t)(t + 1) * kstep;
            const char* a2 = last ? nA : cA + (size_t)(t + 2) * kstep; const char* b2 = last ? nB : cB + (size_t)(t + 2) * kstep;
            const char* a3 = a2 + kstep; const char* b3 = b2 + kstep;
            PG8_LDB(B0, 0, 0); PG8_LDB(B1, 0, 1); PG8_SCHED; PG8_LDA(At, 0, 0); PG8_STAGE(PG8_SA(1, 1), a1 + hstep, voffA);
            PG8_WAIT_V(8); PG8_WAIT_L(0); PG8_BAR; PG8_MMA(0, 0, At, B0); PG8_MMA(0, 1, At, B1); PG8_BAR; PG8_SCHED;
            PG8_LDA(At, 0, 1); PG8_STAGE(PG8_SB(0, 0), b2, voffB); PG8_STAGE(PG8_SB(0, 1), b2 + hstep, voffB); PG8_STAGE(PG8_SA(0, 0), a2, voffA);
            PG8_WAIT_V(8); PG8_WAIT_L(0); PG8_BAR; PG8_MMA(1, 0, At, B0); PG8_MMA(1, 1, At, B1); PG8_BAR; PG8_SCHED;
            PG8_LDB(B0, 1, 0); PG8_LDB(B1, 1, 1); PG8_SCHED; PG8_LDA(At, 1, 0); PG8_STAGE(PG8_SA(0, 1), a2 + hstep, voffA);
            PG8_WAIT_V(8); PG8_WAIT_L(0); PG8_BAR; PG8_MMA(0, 0, At, B0); PG8_MMA(0, 1, At, B1); PG8_BAR; PG8_SCHED;
            PG8_LDA(At, 1, 1); PG8_STAGE(PG8_SB(1, 0), b3, voffB); PG8_STAGE(PG8_SB(1, 1), b3 + hstep, voffB); PG8_STAGE(PG8_SA(1, 0), a3, voffA);
            PG8_WAIT_V(8); PG8_WAIT_L(0); PG8_BAR; PG8_MMA(1, 0, At, B0); PG8_MMA(1, 1, At, B1); PG8_BAR; PG8_SCHED;
        }
        if (wr == 0) PG8_BAR;
        E(acc, cur, wr, wc, fr, fq, lds, tid);
#ifdef DUP_EPI
        if constexpr (Epi::PERM && sizeof(Epi) == sizeof(EpiStore<2>)) { if (g.N == FF) E(acc, cur, wr, wc, fr, fq, lds, tid); }
#endif
        if (!has_next) break;
#pragma unroll
        for (int a = 0; a < 2; ++a)
#pragma unroll
            for (int b = 0; b < 2; ++b)
#pragma unroll
                for (int m = 0; m < 4; ++m)
#pragma unroll
                    for (int n = 0; n < 2; ++n) acc[a][b][m][n] = (f32x4){0.f, 0.f, 0.f, 0.f};
        cur = nxt; cA = nA; cB = nB; ++ui;
        if (wr == 1) PG8_BAR;
    }
    PG8_WAIT_V(0);
    PG8_BAR;
#undef PG8_SA
#undef PG8_SB
#undef PG8_STAGE
#undef PG8_LDA
#undef PG8_LDB
#undef PG8_MMA
#undef PG8_WAIT_V
#undef PG8_WAIT_L
#undef PG8_BAR
#undef PG8_SCHED
}
}

namespace att {
constexpr int KVBLK = 64;
constexpr int SHM_V = 16384, SHM_K = 16384;
constexpr int SLOT = 32768, L_V = 0, L_K = 16384, L_WS = 98304, L_TAB = 100352, L_EX = 0;
constexpr int TABN = 373, TABC = 186;
constexpr float THR = 12.f;
#define KSWZ(row, colB) ((row) * 256 + ((colB) ^ (((row) & 15) << 4)))
#define SBAR() __builtin_amdgcn_sched_barrier(0)
__device__ __forceinline__ int crow(int r, int hi) { return (r & 3) + 8 * (r >> 2) + 4 * hi; }

__device__ __forceinline__ void partialSM(f32x16& p0, f32x16& p1, float& e_reg, float& cbprev, float cb, float& alpha) {
  float pmax = p0[0];
#pragma unroll
  for (int r = 1; r < 16; ++r) pmax = fmaxf(pmax, p0[r]);
#pragma unroll
  for (int r = 0; r < 16; ++r) pmax = fmaxf(pmax, p1[r]);
  { auto rr = __builtin_amdgcn_permlane32_swap(__float_as_uint(pmax), __float_as_uint(pmax), false, false);
    pmax = fmaxf(__uint_as_float(rr[0]), __uint_as_float(rr[1])); }
  float sh = e_reg - cb;
  if (__builtin_expect(cb == cbprev && __all(pmax - sh <= THR), 1)) { alpha = 1.f; }
  else { const bool ok0 = (pmax <= THR) && (pmax >= -THR) && (sh <= THR);
    sh = ok0 ? 0.f : fmaxf(pmax, sh);
    const float en = sh + cb; alpha = __builtin_amdgcn_exp2f(e_reg - en); e_reg = en; }
  cbprev = cb;
  if (!__all(sh == 0.f)) {
#pragma unroll
    for (int r = 0; r < 16; ++r) p0[r] = p0[r] - sh;
#pragma unroll
    for (int r = 0; r < 16; ++r) p1[r] = p1[r] - sh;
  }
#pragma unroll
  for (int r = 0; r < 16; ++r) p0[r] = __builtin_amdgcn_exp2f(p0[r]);
#ifdef EXP_ALL_IN_PARTIAL
#pragma unroll
  for (int r = 0; r < 16; ++r) p1[r] = __builtin_amdgcn_exp2f(p1[r]);
#endif
}
__device__ __forceinline__ void finishSM(f32x16& p0, f32x16& p1, float alpha, float& l_reg, bf16x8& pa0, bf16x8& pa1, bf16x8& pa2, bf16x8& pa3) {
#ifndef EXP_ALL_IN_PARTIAL
#pragma unroll
  for (int r = 0; r < 16; ++r) p1[r] = __builtin_amdgcn_exp2f(p1[r]);
#endif
  float ps = 0;
#pragma unroll
  for (int r = 0; r < 16; ++r) ps += p0[r];
#pragma unroll
  for (int r = 0; r < 16; ++r) ps += p1[r];
  { auto rr = __builtin_amdgcn_permlane32_swap(__float_as_uint(ps), __float_as_uint(ps), false, false);
    ps = __uint_as_float(rr[0]) + __uint_as_float(rr[1]); }
  l_reg = l_reg * alpha + ps;
#define PK4(P, BASE, OUT) do { unsigned a0 = cvt_pk_bf16(P[BASE + 0], P[BASE + 1]), a1 = cvt_pk_bf16(P[BASE + 2], P[BASE + 3]);   \
    unsigned b0 = cvt_pk_bf16(P[BASE + 4], P[BASE + 5]), b1 = cvt_pk_bf16(P[BASE + 6], P[BASE + 7]);                              \
    auto r0 = __builtin_amdgcn_permlane32_swap(a0, b0, false, false); auto r1 = __builtin_amdgcn_permlane32_swap(a1, b1, false, false); \
    u32x4 w = {r0[0], r1[0], r0[1], r1[1]}; OUT = *reinterpret_cast<bf16x8*>(&w); } while (0)
  PK4(p0, 0, pa0); PK4(p0, 8, pa1); PK4(p1, 0, pa2); PK4(p1, 8, pa3);
#undef PK4
}
template <bool SEEDED> __device__ __forceinline__ void qkt(f32x16& p0, f32x16& p1, const char* Ks, const bf16x8* qr, int r32, int cbase) {
#pragma unroll
  for (int d0 = 0; d0 < 4; ++d0) { const int cb = cbase + d0 * 32;
    bf16x8 b0 = *reinterpret_cast<const bf16x8*>(Ks + KSWZ(r32, cb));
    bf16x8 b1 = *reinterpret_cast<const bf16x8*>(Ks + KSWZ(32 + r32, cb));
    if (!SEEDED && d0 == 0) { p0 = __builtin_amdgcn_mfma_f32_32x32x16_bf16(b0, qr[0], f32x16{}, 0, 0, 0); p1 = __builtin_amdgcn_mfma_f32_32x32x16_bf16(b1, qr[0], f32x16{}, 0, 0, 0); }
    else { p0 = __builtin_amdgcn_mfma_f32_32x32x16_bf16(b0, qr[d0], p0, 0, 0, 0); p1 = __builtin_amdgcn_mfma_f32_32x32x16_bf16(b1, qr[d0], p1, 0, 0, 0); } }
}
__device__ __forceinline__ int v_st(int k, int c) { const int kk = (k & ~0xC) | ((k & 4) << 1) | ((k & 8) >> 1); return ((kk >> 3) * 4 + (c >> 5)) * 512 + ((kk & 7) * 32 + (c & 31)) * 2; }
__device__ __forceinline__ int v_rd_base(int lane) { return ((lane & 3) << 3) | (((lane >> 2) & 3) << 6) | (((lane >> 4) & 1) << 5) | (((lane >> 5) & 1) << 8); }
constexpr int v_rd_off(int d0, int ks, int half) { return d0 * 512 + ks * 4096 + half * 2048; }
template <int OFF> __device__ __forceinline__ s16x4 tr_read(int vb) {
  s16x4 r; asm volatile("ds_read_b64_tr_b16 %0, %1 offset:%2" : "=&v"(r) : "v"(vb), "i"(OFF) : "memory"); return r;
}
template <int D0> __device__ __forceinline__ void pv_one(f32x16& od, int vb, bf16x8 pa0, bf16x8 pa1, bf16x8 pa2, bf16x8 pa3) {
  const s16x4 l0 = tr_read<v_rd_off(D0, 0, 0)>(vb), h0 = tr_read<v_rd_off(D0, 0, 1)>(vb), l1 = tr_read<v_rd_off(D0, 1, 0)>(vb), h1 = tr_read<v_rd_off(D0, 1, 1)>(vb);
  const s16x4 l2 = tr_read<v_rd_off(D0, 2, 0)>(vb), h2 = tr_read<v_rd_off(D0, 2, 1)>(vb), l3 = tr_read<v_rd_off(D0, 3, 0)>(vb), h3 = tr_read<v_rd_off(D0, 3, 1)>(vb);
  asm volatile("s_waitcnt lgkmcnt(0)" ::: "memory"); SBAR();
#define PK(L, H) (bf16x8){L[0], L[1], L[2], L[3], H[0], H[1], H[2], H[3]}
  od = __builtin_amdgcn_mfma_f32_32x32x16_bf16(pa0, PK(l0, h0), od, 0, 0, 0);
  od = __builtin_amdgcn_mfma_f32_32x32x16_bf16(pa1, PK(l1, h1), od, 0, 0, 0);
  od = __builtin_amdgcn_mfma_f32_32x32x16_bf16(pa2, PK(l2, h2), od, 0, 0, 0);
  od = __builtin_amdgcn_mfma_f32_32x32x16_bf16(pa3, PK(l3, h3), od, 0, 0, 0);
#undef PK
}
template <int D0> __device__ __forceinline__ void pv_reads(s16x4 (&L)[8], int vb) {
  L[0] = tr_read<v_rd_off(D0, 0, 0)>(vb); L[1] = tr_read<v_rd_off(D0, 0, 1)>(vb); L[2] = tr_read<v_rd_off(D0, 1, 0)>(vb); L[3] = tr_read<v_rd_off(D0, 1, 1)>(vb);
  L[4] = tr_read<v_rd_off(D0, 2, 0)>(vb); L[5] = tr_read<v_rd_off(D0, 2, 1)>(vb); L[6] = tr_read<v_rd_off(D0, 3, 0)>(vb); L[7] = tr_read<v_rd_off(D0, 3, 1)>(vb);
}
__device__ __forceinline__ void pv_mma(f32x16& od, const s16x4 (&L)[8], bf16x8 pa0, bf16x8 pa1, bf16x8 pa2, bf16x8 pa3) {
#define PK(A, B) (bf16x8){A[0], A[1], A[2], A[3], B[0], B[1], B[2], B[3]}
  od = __builtin_amdgcn_mfma_f32_32x32x16_bf16(pa0, PK(L[0], L[1]), od, 0, 0, 0);
  od = __builtin_amdgcn_mfma_f32_32x32x16_bf16(pa1, PK(L[2], L[3]), od, 0, 0, 0);
  od = __builtin_amdgcn_mfma_f32_32x32x16_bf16(pa2, PK(L[4], L[5]), od, 0, 0, 0);
  od = __builtin_amdgcn_mfma_f32_32x32x16_bf16(pa3, PK(L[6], L[7]), od, 0, 0, 0);
#undef PK
}
template <bool MEM> __device__ __forceinline__ void pv_all(f32x16* o, int vb, bf16x8 pa0, bf16x8 pa1, bf16x8 pa2, bf16x8 pa3) {
#ifndef NO_PV_PIPE
  s16x4 LA[8], LB[8];
  pv_reads<0>(LA, vb); pv_reads<1>(LB, vb);
  asm volatile("s_waitcnt lgkmcnt(8)" ::: "memory"); SBAR(); pv_mma(o[0], LA, pa0, pa1, pa2, pa3); SBAR();
  if constexpr (!MEM) {
    pv_reads<2>(LA, vb);
    asm volatile("s_waitcnt lgkmcnt(8)" ::: "memory"); SBAR(); pv_mma(o[1], LB, pa0, pa1, pa2, pa3); SBAR();
    pv_reads<3>(LB, vb);
    asm volatile("s_waitcnt lgkmcnt(8)" ::: "memory"); SBAR(); pv_mma(o[2], LA, pa0, pa1, pa2, pa3); SBAR();
    asm volatile("s_waitcnt lgkmcnt(0)" ::: "memory"); SBAR(); pv_mma(o[3], LB, pa0, pa1, pa2, pa3);
  } else {
    asm volatile("s_waitcnt lgkmcnt(0)" ::: "memory"); SBAR(); pv_mma(o[1], LB, pa0, pa1, pa2, pa3);
  }
#else
  pv_one<0>(o[0], vb, pa0, pa1, pa2, pa3); pv_one<1>(o[1], vb, pa0, pa1, pa2, pa3);
  if constexpr (!MEM) { pv_one<2>(o[2], vb, pa0, pa1, pa2, pa3); pv_one<3>(o[3], vb, pa0, pa1, pa2, pa3); }
#endif
}

template <bool MEM>
__device__ __forceinline__ void attn_unit(const bf16_t* __restrict__ Qg, int ldq, const bf16_t* __restrict__ Kg, const bf16_t* __restrict__ Vg, int ldk,
                                          bf16_t* __restrict__ Og, int q0pos, const LAS float* tab, float lam, float oscale, const float* __restrict__ gnorm, char* lds) {
  constexpr int NT = MEM ? (MEML / KVBLK) : (SEQ / KVBLK); constexpr int ND = MEM ? 2 : 4;
  const int tid = opaque_tid(), wid = __builtin_amdgcn_readfirstlane(tid >> 6), lane = tid & 63, r32 = lane & 31, hi = lane >> 5;
  const int half = wid >> 2, wq = wid & 3;
  char* V_lds = lds + L_V; char* K_lds = lds + L_K;
  float* ws = (float*)(lds + L_WS) + wid * 64; float* li_l = ws; float* al_l = ws + 32;
  float m_reg = -1e30f, l_reg = 0; f32x16 o[ND];
#pragma unroll
  for (int d = 0; d < ND; ++d) o[d] = f32x16{};
  bf16x8 qr[4];
  const bf16_t* Qw = Qg + (long)(wq * 32 + r32) * ldq + half * 64 + hi * 8;
#pragma unroll
  for (int d0 = 0; d0 < 4; ++d0) qr[d0] = *reinterpret_cast<const bf16x8*>(Qw + d0 * 16);
  const int vb0 = (int)(uintptr_t)V_lds + v_rd_base(lane) + (MEM ? half * 1024 : 0);
  const int cbase = half * 128 + hi * 16;
  const int q0w = q0pos + wq * 32;
  float cL = 0.f, cR = 0.f;
  if constexpr (!MEM) { cL = tab[0]; cR = tab[TABN - 1]; }
  unsigned koff[2], voff[2];
#pragma unroll
  for (int i = 0; i < 2; ++i) { const int p = 2 * wid + i;
    { const int row = 4 * p + (lane >> 4), chunk = (lane & 15) ^ (row & 15); koff[i] = (unsigned)(row * ldk + chunk * 8) * 2u; }
    { const int st = 2 * p + (lane >> 5), kk = (st >> 2) * 8 + ((lane >> 2) & 7), k = (kk & ~0xC) | ((kk & 4) << 1) | ((kk & 8) >> 1), c = (st & 3) * 32 + (lane & 3) * 8; voff[i] = (unsigned)(k * ldk + c) * 2u; } }
  LAS unsigned char* ldsA = (LAS unsigned char*)lds;
  const size_t tile_bytes = (size_t)KVBLK * ldk * 2;
#define DMA(t, sl) do { const char* kb_ = (const char*)Kg + (size_t)(t) * tile_bytes; const char* vb_ = (const char*)Vg + (size_t)(t) * tile_bytes; \
    _Pragma("unroll") for (int i_ = 0; i_ < 2; ++i_) { \
      __builtin_amdgcn_global_load_lds((const unsigned*)(kb_ + koff[i_]), (LAS unsigned*)(ldsA + (sl) + L_K + (2 * wid + i_) * 1024), 16, 0, 0); \
      __builtin_amdgcn_global_load_lds((const unsigned*)(vb_ + voff[i_]), (LAS unsigned*)(ldsA + (sl) + L_V + (2 * wid + i_) * 1024), 16, 0, 0); } } while (0)
#define BARRIER() asm volatile("s_waitcnt vmcnt(0) lgkmcnt(0)\n\ts_barrier" ::: "memory")
#define RESC(a) do { if (__any((a) != 1.f)) { if (hi == 0) al_l[r32] = (a); asm volatile("s_waitcnt lgkmcnt(0)" ::: "memory"); \
    _Pragma("unroll") for (int d = 0; d < ND; ++d) _Pragma("unroll") for (int r = 0; r < 16; ++r) o[d][r] *= al_l[crow(r, hi)]; } } while (0)
#define SCORES_FIN(P0, P1, CB, Kbuf, j, FIN) do { bool band_ = false; int dq_ = 0; if constexpr (!MEM) { dq_ = (j) * KVBLK - q0w; band_ = (dq_ >= -128 && dq_ <= 96); } \
    if (band_) { const LAS float* tb = tab + (dq_ + 4 * hi - r32 + TABC); \
      _Pragma("unroll") for (int r = 0; r < 16; ++r) { P0[r] = tb[(r & 3) + 8 * (r >> 2)]; P1[r] = tb[32 + (r & 3) + 8 * (r >> 2)]; } \
      CB = 0.f; SBAR(); qkt<true>(P0, P1, Kbuf, qr, r32, cbase); FIN; SBAR(); } \
    else { CB = MEM ? 0.f : (dq_ > 0 ? cR : cL); SBAR(); qkt<false>(P0, P1, Kbuf, qr, r32, cbase); FIN; SBAR(); } } while (0)
#define SCORES(P0, P1, CB, Kbuf, j) SCORES_FIN(P0, P1, CB, Kbuf, j, (void)0)
  f32x16 pA0, pA1, pB0, pB1; float alA, alB, cbA, cbB, cbprev = 0.f; bf16x8 pa0, pa1, pa2, pa3;
  int sl_prev = 0, sl_cur = SLOT, sl_next = 2 * SLOT;
#define ROT() do { const int t_ = sl_prev; sl_prev = sl_cur; sl_cur = sl_next; sl_next = t_; } while (0)
#define STEP(PC0, PC1, ALC, CBC, PP0, PP1, ALP, j) do { BARRIER(); if ((j) + 1 < NT) DMA((j) + 1, sl_next); \
    SCORES_FIN(PC0, PC1, CBC, K_lds + sl_cur, j, finishSM(PP0, PP1, ALP, l_reg, pa0, pa1, pa2, pa3)); \
    pv_all<MEM>(o, vb0 + sl_prev, pa0, pa1, pa2, pa3); partialSM(PC0, PC1, m_reg, cbprev, CBC, ALC); \
    RESC(ALC); ROT(); } while (0)
  DMA(0, 0); DMA(1, SLOT);
  BARRIER();
  SCORES(pA0, pA1, cbA, K_lds, 0); partialSM(pA0, pA1, m_reg, cbprev, cbA, alA);
  for (int j = 1; j + 1 < NT; j += 2) {
    STEP(pB0, pB1, alB, cbB, pA0, pA1, alA, j);
    STEP(pA0, pA1, alA, cbA, pB0, pB1, alB, j + 1);
  }
  STEP(pB0, pB1, alB, cbB, pA0, pA1, alA, NT - 1);
  finishSM(pB0, pB1, alB, l_reg, pa0, pa1, pa2, pa3); SBAR();
  pv_all<MEM>(o, vb0 + sl_prev, pa0, pa1, pa2, pa3);
  BARRIER();
  if (hi == 0) li_l[r32] = l_reg; asm volatile("s_waitcnt lgkmcnt(0)" ::: "memory");
  float rli[16];
#pragma unroll
  for (int r = 0; r < 16; ++r) rli[r] = __builtin_amdgcn_rcpf(li_l[crow(r, hi)]);
  if constexpr (MEM) {
    bf16_t* Ow = Og + (long)(wq * 32) * DM + half * 64;
#pragma unroll
    for (int r = 0; r < 16; ++r) { const int orow = crow(r, hi);
#pragma unroll
      for (int d0 = 0; d0 < 2; ++d0) Ow[(long)orow * DM + d0 * 32 + r32] = (bf16_t)(cvt_pk_bf16(o[d0][r] * rli[r], 0.f) & 0xffffu); }
  } else {
    LAS float* ex = (LAS float*)((LAS char*)lds + L_EX) + wq * 4096 + lane;
    if (half == 1) {
#pragma unroll
      for (int d0 = 0; d0 < 4; ++d0)
#pragma unroll
        for (int r = 0; r < 16; ++r) ex[(d0 * 16 + r) * 64] = o[d0][r] * rli[r];
    }
    __syncthreads();
    if (half == 0) {
      float ss[16];
#pragma unroll
      for (int r = 0; r < 16; ++r) { float s = 0.f;
#pragma unroll
        for (int d0 = 0; d0 < 4; ++d0) { const float x = o[d0][r] * rli[r] - lam * ex[(d0 * 16 + r) * 64]; o[d0][r] = x; s += x * x; }
        ss[r] = s; }
#pragma unroll
      for (int off = 1; off < 32; off <<= 1)
#pragma unroll
        for (int r = 0; r < 16; ++r) ss[r] += shfl_xor_f(ss[r], off);
      float gv[4];
#pragma unroll
      for (int d0 = 0; d0 < 4; ++d0) gv[d0] = gnorm[d0 * 32 + r32] * oscale;
      bf16_t* Ow = Og + (long)(wq * 32) * DM;
#pragma unroll
      for (int r = 0; r < 16; ++r) { const int orow = crow(r, hi); const float rs = __builtin_amdgcn_rsqf(ss[r] * (1.f / 128.f) + LN_EPS);
#pragma unroll
        for (int d0 = 0; d0 < 4; ++d0) Ow[(long)orow * DM + d0 * 32 + r32] = (bf16_t)(cvt_pk_bf16(o[d0][r] * rs * gv[d0], 0.f) & 0xffffu); }
    }
  }
  if constexpr (!MEM) BARRIER();
#undef DMA
#undef BARRIER
#undef STEP
#undef ROT
#undef RESC
#undef SCORES
#undef SCORES_FIN
}
template <int D0> __device__ __forceinline__ void pv_rd(s16x4 (&L)[8], int vb) {
  L[0] = tr_read<v_rd_off(D0, 0, 0)>(vb); L[1] = tr_read<v_rd_off(D0, 0, 1)>(vb); L[2] = tr_read<v_rd_off(D0, 1, 0)>(vb); L[3] = tr_read<v_rd_off(D0, 1, 1)>(vb);
  L[4] = tr_read<v_rd_off(D0, 2, 0)>(vb); L[5] = tr_read<v_rd_off(D0, 2, 1)>(vb); L[6] = tr_read<v_rd_off(D0, 3, 0)>(vb); L[7] = tr_read<v_rd_off(D0, 3, 1)>(vb);
}
__device__ __forceinline__ void pv_mma2(f32x16& oa, f32x16& ob, const s16x4 (&L)[8], const bf16x8 (&pa)[4], const bf16x8 (&pb)[4]) {
#define PKV(a) (bf16x8){L[a][0], L[a][1], L[a][2], L[a][3], L[(a) + 1][0], L[(a) + 1][1], L[(a) + 1][2], L[(a) + 1][3]}
  oa = __builtin_amdgcn_mfma_f32_32x32x16_bf16(pa[0], PKV(0), oa, 0, 0, 0); ob = __builtin_amdgcn_mfma_f32_32x32x16_bf16(pb[0], PKV(0), ob, 0, 0, 0);
  oa = __builtin_amdgcn_mfma_f32_32x32x16_bf16(pa[1], PKV(2), oa, 0, 0, 0); ob = __builtin_amdgcn_mfma_f32_32x32x16_bf16(pb[1], PKV(2), ob, 0, 0, 0);
  oa = __builtin_amdgcn_mfma_f32_32x32x16_bf16(pa[2], PKV(4), oa, 0, 0, 0); ob = __builtin_amdgcn_mfma_f32_32x32x16_bf16(pb[2], PKV(4), ob, 0, 0, 0);
  oa = __builtin_amdgcn_mfma_f32_32x32x16_bf16(pa[3], PKV(6), oa, 0, 0, 0); ob = __builtin_amdgcn_mfma_f32_32x32x16_bf16(pb[3], PKV(6), ob, 0, 0, 0);
#undef PKV
}
template <bool MEM> __device__ __forceinline__ void pv_all2(f32x16* oa, f32x16* ob, int vb, const bf16x8 (&pa)[4], const bf16x8 (&pb)[4]) {
  s16x4 LA[8], LB[8];
  pv_rd<0>(LA, vb); pv_rd<1>(LB, vb);
  asm volatile("s_waitcnt lgkmcnt(8)" ::: "memory"); SBAR(); pv_mma2(oa[0], ob[0], LA, pa, pb); SBAR();
  if constexpr (!MEM) {
    pv_rd<2>(LA, vb);
    asm volatile("s_waitcnt lgkmcnt(8)" ::: "memory"); SBAR(); pv_mma2(oa[1], ob[1], LB, pa, pb); SBAR();
    pv_rd<3>(LB, vb);
    asm volatile("s_waitcnt lgkmcnt(8)" ::: "memory"); SBAR(); pv_mma2(oa[2], ob[2], LA, pa, pb); SBAR();
    asm volatile("s_waitcnt lgkmcnt(0)" ::: "memory"); SBAR(); pv_mma2(oa[3], ob[3], LB, pa, pb);
  } else {
    asm volatile("s_waitcnt lgkmcnt(0)" ::: "memory"); SBAR(); pv_mma2(oa[1], ob[1], LB, pa, pb);
  }
}
template <bool SA, bool SB>
__device__ __forceinline__ void qkt2(f32x16& a0, f32x16& a1, f32x16& b0, f32x16& b1, const char* Ks, const LAS bf16x8* qp, int r32, int cbase) {
#pragma unroll
  for (int d0 = 0; d0 < 4; ++d0) { const int cb = cbase + d0 * 32;
    const bf16x8 k0 = *reinterpret_cast<const bf16x8*>(Ks + KSWZ(r32, cb)), k1 = *reinterpret_cast<const bf16x8*>(Ks + KSWZ(32 + r32, cb));
    const bf16x8 qa = qp[d0 * 64], qb = qp[(4 + d0) * 64];
    if (!SA && d0 == 0) { a0 = __builtin_amdgcn_mfma_f32_32x32x16_bf16(k0, qa, f32x16{}, 0, 0, 0); a1 = __builtin_amdgcn_mfma_f32_32x32x16_bf16(k1, qa, f32x16{}, 0, 0, 0); }
    else { a0 = __builtin_amdgcn_mfma_f32_32x32x16_bf16(k0, qa, a0, 0, 0, 0); a1 = __builtin_amdgcn_mfma_f32_32x32x16_bf16(k1, qa, a1, 0, 0, 0); }
    if (!SB && d0 == 0) { b0 = __builtin_amdgcn_mfma_f32_32x32x16_bf16(k0, qb, f32x16{}, 0, 0, 0); b1 = __builtin_amdgcn_mfma_f32_32x32x16_bf16(k1, qb, f32x16{}, 0, 0, 0); }
    else { b0 = __builtin_amdgcn_mfma_f32_32x32x16_bf16(k0, qb, b0, 0, 0, 0); b1 = __builtin_amdgcn_mfma_f32_32x32x16_bf16(k1, qb, b1, 0, 0, 0); } }
}
constexpr int L2_KRING = 49152, L2_WS = 81920, L2_TAB = 83968, L2_EX = 90112;
template <bool MEM>
__device__ __forceinline__ void attn_unit2(const bf16_t* __restrict__ Qg, int ldq, const bf16_t* __restrict__ Kg, const bf16_t* __restrict__ Vg, int ldk,
                                           bf16_t* __restrict__ Og, int q0pos, const LAS float* tab, float lam, float oscale, const float* __restrict__ gnorm, char* lds) {
  constexpr int NT = MEM ? (MEML / KVBLK) : (SEQ / KVBLK); constexpr int ND = MEM ? 2 : 4;
  const int tid = opaque_tid(), wid = __builtin_amdgcn_readfirstlane(tid >> 6), lane = tid & 63, r32 = lane & 31, hi = lane >> 5;
  const int half = wid >> 2, wq = wid & 3;
  char* V_lds = lds; char* K_lds = lds + L2_KRING;
  float* ws = (float*)(lds + L2_WS) + wid * 64; float* li_l = ws; float* al_l = ws + 32;
  float mA = -1e30f, mB = -1e30f, lA = 0.f, lB = 0.f, cbpA = 0.f, cbpB = 0.f; f32x16 oA[ND], oB[ND];
#pragma unroll
  for (int d = 0; d < ND; ++d) { oA[d] = f32x16{}; oB[d] = f32x16{}; }
  LAS bf16x8* qpark = (LAS bf16x8*)((LAS char*)lds + L2_EX) + wid * 512 + lane;
  { const bf16_t* Qw = Qg + (long)(wq * 64 + r32) * ldq + half * 64 + hi * 8;
#pragma unroll
    for (int d0 = 0; d0 < 4; ++d0) { qpark[d0 * 64] = *reinterpret_cast<const bf16x8*>(Qw + d0 * 16); qpark[(4 + d0) * 64] = *reinterpret_cast<const bf16x8*>(Qw + (long)32 * ldq + d0 * 16); } }
  const int vb0 = (int)(uintptr_t)V_lds + v_rd_base(lane) + (MEM ? half * 1024 : 0);
  const int cbase = half * 128 + hi * 16;
  const int q0wA = q0pos + wq * 64, q0wB = q0wA + 32;
  float cL = 0.f, cR = 0.f;
  if constexpr (!MEM) { cL = tab[0]; cR = tab[TABN - 1]; }
  unsigned koff[2], voff[2];
#pragma unroll
  for (int i = 0; i < 2; ++i) { const int p = 2 * wid + i;
    { const int row = 4 * p + (lane >> 4), chunk = (lane & 15) ^ (row & 15); koff[i] = (unsigned)(row * ldk + chunk * 8) * 2u; }
    { const int st = 2 * p + (lane >> 5), kk = (st >> 2) * 8 + ((lane >> 2) & 7), k = (kk & ~0xC) | ((kk & 4) << 1) | ((kk & 8) >> 1), c = (st & 3) * 32 + (lane & 3) * 8; voff[i] = (unsigned)(k * ldk + c) * 2u; } }
  LAS unsigned char* ldsA = (LAS unsigned char*)lds;
  const size_t tile_bytes = (size_t)KVBLK * ldk * 2;
#define DMA(t, ksl, vsl) do { const char* kb_ = (const char*)Kg + (size_t)(t) * tile_bytes; const char* vb_ = (const char*)Vg + (size_t)(t) * tile_bytes; \
    _Pragma("unroll") for (int i_ = 0; i_ < 2; ++i_) { \
      __builtin_amdgcn_global_load_lds((const unsigned*)(kb_ + koff[i_]), (LAS unsigned*)(ldsA + L2_KRING + (ksl) + (2 * wid + i_) * 1024), 16, 0, 0); \
      __builtin_amdgcn_global_load_lds((const unsigned*)(vb_ + voff[i_]), (LAS unsigned*)(ldsA + (vsl) + (2 * wid + i_) * 1024), 16, 0, 0); } } while (0)
#define BARRIER() asm volatile("s_waitcnt vmcnt(0) lgkmcnt(0)\n\ts_barrier" ::: "memory")
#define RESC2(O, a) do { if (__any((a) != 1.f)) { if (hi == 0) al_l[r32] = (a); asm volatile("s_waitcnt lgkmcnt(0)" ::: "memory"); \
    _Pragma("unroll") for (int d = 0; d < ND; ++d) _Pragma("unroll") for (int r = 0; r < 16; ++r) O[d][r] *= al_l[crow(r, hi)]; } } while (0)
#define SEEDT(C0, C1, DQ) do { const LAS float* tb = tab + ((DQ) + 4 * hi - r32 + TABC); \
    _Pragma("unroll") for (int r = 0; r < 16; ++r) { C0[r] = tb[(r & 3) + 8 * (r >> 2)]; C1[r] = tb[32 + (r & 3) + 8 * (r >> 2)]; } } while (0)
#define SMONLY(PA, C0, C1, CB, O, L_, M_, CBP) do { float al_; partialSM(C0, C1, M_, CBP, CB, al_); RESC2(O, al_); \
    finishSM(C0, C1, al_, L_, PA[0], PA[1], PA[2], PA[3]); SBAR(); } while (0)
#define QKSM(j, sl) do { f32x16 a0_, a1_, b0_, b1_; float cba_ = 0.f, cbb_ = 0.f; \
    if constexpr (MEM) { qkt2<false, false>(a0_, a1_, b0_, b1_, K_lds + (sl), qpark, r32, cbase); } \
    else { const int dqa_ = (j) * KVBLK - q0wA, dqb_ = dqa_ - 32; const bool ba_ = (dqa_ >= -128 && dqa_ <= 96), bb_ = (dqb_ >= -128 && dqb_ <= 96); \
      cba_ = ba_ ? 0.f : (dqa_ > 0 ? cR : cL); cbb_ = bb_ ? 0.f : (dqb_ > 0 ? cR : cL); \
      if (!ba_ && !bb_) { qkt2<false, false>(a0_, a1_, b0_, b1_, K_lds + (sl), qpark, r32, cbase); } \
      else if (ba_ && bb_) { SEEDT(a0_, a1_, dqa_); SEEDT(b0_, b1_, dqb_); qkt2<true, true>(a0_, a1_, b0_, b1_, K_lds + (sl), qpark, r32, cbase); } \
      else if (ba_) { SEEDT(a0_, a1_, dqa_); qkt2<true, false>(a0_, a1_, b0_, b1_, K_lds + (sl), qpark, r32, cbase); } \
      else { SEEDT(b0_, b1_, dqb_); qkt2<false, true>(a0_, a1_, b0_, b1_, K_lds + (sl), qpark, r32, cbase); } } \
    SMONLY(pA_, a0_, a1_, cba_, oA, lA, mA, cbpA); \
    SMONLY(pB_, b0_, b1_, cbb_, oB, lB, mB, cbpB); } while (0)
  bf16x8 pA_[4], pB_[4];
  int v_prev = 0, v_cur = 0, v_next = 16384;
#define VROT() do { v_prev = v_cur; v_cur = v_next; v_next = (v_next == 32768) ? 0 : v_next + 16384; } while (0)
  DMA(0, 0, 0);
  if (half == 0) {
    for (int j = 0; j < NT; ++j) { const int ksl = (j & 1) * 16384;
      BARRIER(); if (j + 1 < NT) DMA(j + 1, 16384 - ksl, v_next);
      QKSM(j, ksl);
      pv_all2<MEM>(oA, oB, vb0 + v_cur, pA_, pB_); VROT(); }
  } else {
    for (int j = 0; j < NT; ++j) { const int ksl = (j & 1) * 16384;
      BARRIER(); if (j + 1 < NT) DMA(j + 1, 16384 - ksl, v_next);
      if (j > 0) pv_all2<MEM>(oA, oB, vb0 + v_prev, pA_, pB_);
      QKSM(j, ksl); VROT(); }
    pv_all2<MEM>(oA, oB, vb0 + v_prev, pA_, pB_);
  }
  BARRIER();
#define EPI(O, L_, RB) do { if (hi == 0) li_l[r32] = (L_); asm volatile("s_waitcnt lgkmcnt(0)" ::: "memory"); \
    float rli[16]; _Pragma("unroll") for (int r = 0; r < 16; ++r) rli[r] = __builtin_amdgcn_rcpf(li_l[crow(r, hi)]); \
    if constexpr (MEM) { bf16_t* Ow = Og + (long)(wq * 64 + (RB)) * DM + half * 64; \
      _Pragma("unroll") for (int r = 0; r < 16; ++r) { const int orow = crow(r, hi); \
        _Pragma("unroll") for (int d0 = 0; d0 < 2; ++d0) Ow[(long)orow * DM + d0 * 32 + r32] = (bf16_t)(cvt_pk_bf16(O[d0][r] * rli[r], 0.f) & 0xffffu); } } \
    else { LAS float* ex = (LAS float*)((LAS char*)lds + L2_EX) + wq * 4096 + lane; \
      if (half == 1) { _Pragma("unroll") for (int d0 = 0; d0 < 4; ++d0) _Pragma("unroll") for (int r = 0; r < 16; ++r) ex[(d0 * 16 + r) * 64] = O[d0][r] * rli[r]; } \
      __syncthreads(); \
      if (half == 0) { float ss[16]; \
        _Pragma("unroll") for (int r = 0; r < 16; ++r) { float s = 0.f; \
          _Pragma("unroll") for (int d0 = 0; d0 < 4; ++d0) { const float x = O[d0][r] * rli[r] - lam * ex[(d0 * 16 + r) * 64]; O[d0][r] = x; s += x * x; } ss[r] = s; } \
        _Pragma("unroll") for (int off = 1; off < 32; off <<= 1) _Pragma("unroll") for (int r = 0; r < 16; ++r) ss[r] += shfl_xor_f(ss[r], off); \
        float gv[4]; _Pragma("unroll") for (int d0 = 0; d0 < 4; ++d0) gv[d0] = gnorm[d0 * 32 + r32] * oscale; \
        bf16_t* Ow = Og + (long)(wq * 64 + (RB)) * DM; \
        _Pragma("unroll") for (int r = 0; r < 16; ++r) { const int orow = crow(r, hi); const float rs = __builtin_amdgcn_rsqf(ss[r] * (1.f / 128.f) + LN_EPS); \
          _Pragma("unroll") for (int d0 = 0; d0 < 4; ++d0) Ow[(long)orow * DM + d0 * 32 + r32] = (bf16_t)(cvt_pk_bf16(O[d0][r] * rs * gv[d0], 0.f) & 0xffffu); } } \
      __syncthreads(); } } while (0)
  EPI(oA, lA, 0);
  EPI(oB, lB, 32);
#undef EPI
#undef QKSM
#undef VROT
#undef SMONLY
#undef SEEDT
#undef RESC2
#undef DMA
#undef BARRIER
}
#undef SBAR
}

struct Args {
    const float* x; const float* mem; const float* emb_g; const float* emb_b; const float* rel_bias;
    const float* w_in; const float* b_in; const float* conv_w; const float* conv_b; const float* conv_ln_g; const float* conv_ln_b;
    const float* lq1; const float* lk1; const float* lq2; const float* lk2; const float* diff_g; const float* w_mkv;
    const float* w_out; const float* b_out; const float* ln1_g; const float* ln1_b; const float* w_up; const float* w_down; const float* ln2_g; const float* ln2_b;
    float* out; unsigned char* ws;
    float lam_init[4];
};

__device__ __forceinline__ void transpose_item(const float* __restrict__ W, int K, int N, bf16_t* __restrict__ WT, int row_off, LAS float* scr, int item, int lane,
                                               const float* __restrict__ gk, const float* __restrict__ bk, float* __restrict__ pu, float* __restrict__ pv) {
    const int nblk = N / 32, kb = item / nblk, nb = item % nblk, k0 = 64 * kb, n0 = 32 * nb;
    LAS float* sg = scr + 64 * 33;
    { const int c4 = (lane & 7) * 4, r8 = lane >> 3;
      f32x4 t[8];
#pragma unroll
      for (int i = 0; i < 8; ++i) t[i] = *(const f32x4*)(W + (size_t)(k0 + 8 * i + r8) * N + n0 + c4);
#pragma unroll
      for (int i = 0; i < 8; ++i) { LAS float* d = scr + (8 * i + r8) * 33 + c4; d[0] = t[i].x; d[1] = t[i].y; d[2] = t[i].z; d[3] = t[i].w; } }
    if (gk) { sg[lane] = gk[k0 + lane]; sg[64 + lane] = bk[k0 + lane]; } else { sg[lane] = 1.f; }
    asm volatile("s_waitcnt lgkmcnt(0)" ::: "memory");
    const int c = lane & 7;
    float g8[8];
#pragma unroll
    for (int i = 0; i < 8; ++i) g8[i] = sg[8 * c + i];
#pragma unroll
    for (int j = 0; j < 4; ++j) { const int n = (lane >> 3) + 8 * j; const LAS float* s = scr + (8 * c) * 33 + n;
        u32x4 o; o.x = cvt_pk_bf16(s[0 * 33] * g8[0], s[1 * 33] * g8[1]); o.y = cvt_pk_bf16(s[2 * 33] * g8[2], s[3 * 33] * g8[3]);
        o.z = cvt_pk_bf16(s[4 * 33] * g8[4], s[5 * 33] * g8[5]); o.w = cvt_pk_bf16(s[6 * 33] * g8[6], s[7 * 33] * g8[7]);
        *(u32x4*)(WT + (size_t)(row_off + n0 + n) * K + k0 + 8 * c) = o; }
    if (gk) { const int nn = lane & 31, hf = lane >> 5; float su = 0.f, sv = 0.f;
#pragma unroll 8
        for (int k = 0; k < 32; ++k) { const int kk = hf * 32 + k; const float w = scr[kk * 33 + nn];
            su += __uint_as_float(cvt_pk_bf16(w * sg[kk], 0.f) << 16); sv += w * sg[64 + kk]; }
        su += shfl_xor_f(su, 32); sv += shfl_xor_f(sv, 32);
        if (lane < 32) { pu[(size_t)kb * N + n0 + nn] = su; pv[(size_t)kb * N + n0 + nn] = sv; } }
    asm volatile("s_waitcnt lgkmcnt(0)" ::: "memory");
}
__device__ __forceinline__ void ln_row(const float* xrow, float* of, bf16_t* ob, const float* __restrict__ g, const float* __restrict__ b, int lane) {
    const f32x4* xr = (const f32x4*)xrow + lane;
    f32x4 v[4]; float s = 0.f;
#pragma unroll
    for (int j = 0; j < 4; ++j) { v[j] = xr[64 * j]; s += (v[j].x + v[j].y) + (v[j].z + v[j].w); }
    const float mean = wave_sum(s) * (1.f / DM); float s2 = 0.f;
#pragma unroll
    for (int j = 0; j < 4; ++j) { v[j] = v[j] - mean; s2 += (v[j].x * v[j].x + v[j].y * v[j].y) + (v[j].z * v[j].z + v[j].w * v[j].w); }
    const float rstd = __builtin_amdgcn_rsqf(wave_sum(s2) * (1.f / DM) + LN_EPS);
#pragma unroll
    for (int j = 0; j < 4; ++j) { const f32x4 gg = ((const f32x4*)g)[lane + 64 * j], bb = ((const f32x4*)b)[lane + 64 * j];
        const f32x4 y = v[j] * rstd * gg + bb;
        ((f32x4*)of)[lane + 64 * j] = y;
        u32x2 w; w.x = cvt_pk_bf16(y.x, y.y); w.y = cvt_pk_bf16(y.z, y.w); ((u32x2*)ob)[lane + 64 * j] = w; }
}
__device__ __forceinline__ void ln_phase(const float* src, float* dstf, bf16_t* dstb, const float* g, const float* b, int gw, int ngw, int lane_) {
    const int lane = opaque_tid() & 63; (void)lane_;
    for (int m = gw; m < MTOK; m += ngw) ln_row(src + (size_t)m * DM, dstf + (size_t)m * DM, dstb + (size_t)m * DM, g, b, lane);
}
__device__ __forceinline__ void copy_stats_phase(const float* src, bf16_t* dstb, float* st, int gw, int ngw) {
    const int lane = opaque_tid() & 63;
    for (int m = gw; m < MTOK; m += 2 * ngw) {
        const int m2 = (m + ngw < MTOK) ? m + ngw : m;
        const f32x4* xr = (const f32x4*)(src + (size_t)m * DM) + lane; const f32x4* xs = (const f32x4*)(src + (size_t)m2 * DM) + lane;
        f32x4 v[4], u[4];
#pragma unroll
        for (int j = 0; j < 4; ++j) { v[j] = xr[64 * j]; u[j] = xs[64 * j]; }
        float sj[4], qj[4], tj[4], rj[4];
#pragma unroll
        for (int j = 0; j < 4; ++j) { sj[j] = wave_sum((v[j].x + v[j].y) + (v[j].z + v[j].w)); qj[j] = wave_sum((v[j].x * v[j].x + v[j].y * v[j].y) + (v[j].z * v[j].z + v[j].w * v[j].w));
            tj[j] = wave_sum((u[j].x + u[j].y) + (u[j].z + u[j].w)); rj[j] = wave_sum((u[j].x * u[j].x + u[j].y * u[j].y) + (u[j].z * u[j].z + u[j].w * u[j].w)); }
#pragma unroll
        for (int j = 0; j < 4; ++j) { u32x2 w; w.x = cvt_pk_bf16(v[j].x, v[j].y); w.y = cvt_pk_bf16(v[j].z, v[j].w); ((u32x2*)(dstb + (size_t)m * DM))[lane + 64 * j] = w;
            u32x2 y; y.x = cvt_pk_bf16(u[j].x, u[j].y); y.y = cvt_pk_bf16(u[j].z, u[j].w); ((u32x2*)(dstb + (size_t)m2 * DM))[lane + 64 * j] = y; }
        if (lane == 0) { *(f32x4*)(st + (size_t)m * 8) = (f32x4){sj[0], qj[0], sj[1], qj[1]}; *(f32x4*)(st + (size_t)m * 8 + 4) = (f32x4){sj[2], qj[2], sj[3], qj[3]};
            *(f32x4*)(st + (size_t)m2 * 8) = (f32x4){tj[0], rj[0], tj[1], rj[1]}; *(f32x4*)(st + (size_t)m2 * 8 + 4) = (f32x4){tj[2], rj[2], tj[3], rj[3]}; }
    }
}
__device__ __forceinline__ void ln_final_phase(const bf16_t* tb, const float* st, const float* g, const float* b, float* out, int gw, int ngw) {
    const int lane = opaque_tid() & 63;
    for (int m = gw; m < MTOK; m += ngw) {
        float mu, rs; pg8::row_mean_rstd(st, m, mu, rs);
#pragma unroll
        for (int j = 0; j < 4; ++j) { const u32x2 w = ((const u32x2*)(tb + (size_t)m * DM))[lane + 64 * j];
            const f32x4 x = {__uint_as_float(w.x << 16), __uint_as_float(w.x & 0xffff0000u), __uint_as_float(w.y << 16), __uint_as_float(w.y & 0xffff0000u)};
            const f32x4 gg = ((const f32x4*)g)[lane + 64 * j], bb = ((const f32x4*)b)[lane + 64 * j];
            ((f32x4*)(out + (size_t)m * DM))[lane + 64 * j] = (x - mu) * rs * gg + bb; }
    }
}
__device__ __forceinline__ int t5_bucket(int rel) {
    const int n = rel < 0 ? -rel : rel; int b = rel > 0 ? 16 : 0;
    if (n < 8) return b + n;
    int lg = 2 + (31 - __clz(n * n)); if (lg > 15) lg = 15;
    return b + lg;
}

__device__ __forceinline__ void conv_unit(const bf16_t* __restrict__ proj, bf16_t* __restrict__ mixed, const float* __restrict__ cw, const float* __restrict__ cb,
                                          const float* __restrict__ lg, const float* __restrict__ lb, int unit, LAS float* U) {
    const int tid = opaque_tid(), lane = tid & 63, wid = tid >> 6;
    const int b = unit >> 7, t0 = (unit & 127) * 32;
    LAS float* Y = U + 62 * 256;
    for (int task = tid; task < 62 * 32; task += 512) {
        const int rr = task >> 5, ch = (task & 31) * 8; const int t = t0 - 15 + rr;
        f32x4 u0 = {0.f, 0.f, 0.f, 0.f}, u1 = {0.f, 0.f, 0.f, 0.f};
        if (t >= 0 && t < SEQ) {
            const bf16_t* p = proj + (size_t)(b * SEQ + t) * INW + ch;
            const bf16x8 av = *(const bf16x8*)p, gv = *(const bf16x8*)(p + CONVC);
            float uu[8];
#pragma unroll
            for (int i = 0; i < 8; ++i) { const float a = bf2f((unsigned short)av[i]), g = bf2f((unsigned short)gv[i]); uu[i] = a * __builtin_amdgcn_rcpf(1.f + __expf(-g)); }
            u0 = (f32x4){uu[0], uu[1], uu[2], uu[3]}; u1 = (f32x4){uu[4], uu[5], uu[6], uu[7]};
        }
        *(LAS f32x4*)(U + rr * 256 + ch) = u0; *(LAS f32x4*)(U + rr * 256 + ch + 4) = u1;
    }
    __syncthreads();
    const int c = tid & 255, th = tid >> 8;
    float w[CONVW];
#pragma unroll
    for (int j = 0; j < CONVW; ++j) w[j] = cw[j * CONVC + c];
    const float bias = cb[c];
    const LAS float* Ub = U + (th * 16) * 256 + c;
    float uw[46];
#pragma unroll
    for (int i = 0; i < 46; ++i) uw[i] = Ub[i * 256];
#pragma unroll
    for (int t = 0; t < 16; ++t) {
        float s0 = bias, s1 = 0.f;
#pragma unroll
        for (int j = 0; j < CONVW; j += 2) { s0 += w[j] * uw[t + j]; if (j + 1 < CONVW) s1 += w[j + 1] * uw[t + j + 1]; }
        Y[(th * 16 + t) * 256 + c] = s0 + s1;
    }
    __syncthreads();
    const f32x4 gg = ((const f32x4*)lg)[lane], bb = ((const f32x4*)lb)[lane];
#pragma unroll
    for (int k = 0; k < 4; ++k) { const int tok = wid * 4 + k;
        f32x4 y = *(const LAS f32x4*)(Y + tok * 256 + lane * 4);
        const float mean = wave_sum((y.x + y.y) + (y.z + y.w)) * (1.f / 256.f); y = y - mean;
        const float rstd = __builtin_amdgcn_rsqf(wave_sum((y.x * y.x + y.y * y.y) + (y.z * y.z + y.w * y.w)) * (1.f / 256.f) + LN_EPS);
        y = y * rstd * gg + bb;
        f32x4 z; z.x = y.x * __builtin_amdgcn_rcpf(1.f + __expf(-y.x)); z.y = y.y * __builtin_amdgcn_rcpf(1.f + __expf(-y.y));
        z.z = y.z * __builtin_amdgcn_rcpf(1.f + __expf(-y.z)); z.w = y.w * __builtin_amdgcn_rcpf(1.f + __expf(-y.w));
        u32x2 o; o.x = cvt_pk_bf16(z.x, z.y); o.y = cvt_pk_bf16(z.z, z.w);
        *(u32x2*)(mixed + (size_t)(b * SEQ + t0 + tok) * DM + lane * 4) = o; }
    __syncthreads();
}

#define XB_TMO      128
#define XB_XCNT(j)  (256  + 64 * (j))
#define XB_XSUB(j)  (1280 + 64 * (j))
#define XB_XGEN(j)  (2304 + 64 * (j))
#define XB_TOP      3328
#define XB_TOPGEN   3392
#define XCD_BAR_WORDS 3456
#define XB_SPIN_CAP (1u << 18)
__device__ __forceinline__ unsigned xb_ld(unsigned* p)              { return __hip_atomic_load(p, __ATOMIC_RELAXED, __HIP_MEMORY_SCOPE_AGENT); }
__device__ __forceinline__ unsigned xb_add(unsigned* p, unsigned v) { return __hip_atomic_fetch_add(p, v, __ATOMIC_RELAXED, __HIP_MEMORY_SCOPE_AGENT); }
__device__ __forceinline__ unsigned xb_xcc_id() { return (unsigned)__builtin_amdgcn_s_getreg((3 << 11) | 20) & 0xFu; }
#define XB_SPIN(cond, bar) do { unsigned _sp = 0; while (cond) { __builtin_amdgcn_s_sleep(1); \
    if ((++_sp & 255u) == 0u) { if (xb_ld(&(bar)[XB_TMO])) break; if (_sp > XB_SPIN_CAP) { atomicAdd(&(bar)[XB_TMO], 1u); break; } } } } while (0)
struct XcdBarrier { unsigned* bar; unsigned x; volatile LAS unsigned* st; };
__device__ __forceinline__ XcdBarrier xcd_barrier_post(unsigned* bar, volatile LAS unsigned* st) {
    XcdBarrier b; b.bar = bar; b.x = xb_xcc_id(); b.st = st;
    if (threadIdx.x == 0) (void)xb_add(&bar[XB_XCNT(b.x)], 1u);
    return b;
}
__device__ __forceinline__ void xcd_barrier_complete(unsigned* bar, unsigned x, unsigned& nloc, unsigned& nx) {
    const unsigned G = gridDim.x * gridDim.y * gridDim.z;
    unsigned sum, cnt, mine, sp = 0u;
    for (;;) {
        sum = 0u; cnt = 0u; mine = 0u;
#pragma unroll
        for (unsigned j = 0; j < 16; ++j) { const unsigned c = xb_ld(&bar[XB_XCNT(j)]); sum += c; cnt += (c > 0u) ? 1u : 0u; mine = (j == x) ? c : mine; }
        if (sum == G) break;
        __builtin_amdgcn_s_sleep(1);
        if ((++sp & 255u) == 0u) { if (xb_ld(&bar[XB_TMO])) break; if (sp > XB_SPIN_CAP) { atomicAdd(&bar[XB_TMO], 1u); break; } }
    }
    nloc = mine > 0u ? mine : 1u; nx = cnt > 0u ? cnt : 1u;
}
__device__ __forceinline__ void xcd_barrier(const XcdBarrier& b) {
    asm volatile("s_waitcnt vmcnt(0)" ::: "memory");
    __syncthreads();
    if (threadIdx.x == 0) {
        unsigned* bar = b.bar;
        __builtin_amdgcn_s_waitcnt(0);
        unsigned nloc = b.st[0], nx = b.st[1];
        if (nloc == 0u) { xcd_barrier_complete(bar, b.x, nloc, nx); b.st[0] = nloc; b.st[1] = nx; }
        const unsigned old = xb_add(&bar[XB_XSUB(b.x)], 1u);
        const unsigned gen = old / nloc;
        if (old + 1u == (gen + 1u) * nloc) {
            __builtin_amdgcn_fence(__ATOMIC_RELEASE, "agent");
            asm volatile("s_waitcnt vmcnt(0)" ::: "memory");
            const unsigned og = xb_add(&bar[XB_TOP], 1u);
            const unsigned tg = og / nx;
            if (og + 1u == (tg + 1u) * nx) xb_add(&bar[XB_TOPGEN], 1u);
            else XB_SPIN(xb_ld(&bar[XB_TOPGEN]) == tg, bar);
            __builtin_amdgcn_fence(__ATOMIC_ACQUIRE, "agent");
            xb_add(&bar[XB_XGEN(b.x)], 1u);
            asm volatile("s_waitcnt vmcnt(0)" ::: "memory");
        } else {
            XB_SPIN(xb_ld(&bar[XB_XGEN(b.x)]) == gen, bar);
            __builtin_amdgcn_fence(__ATOMIC_ACQUIRE, "agent");
            asm volatile("s_waitcnt vmcnt(0)" ::: "memory");
        }
    }
    __syncthreads();
}

__global__ void __launch_bounds__(NWAVES * 64, 2) mk_fwd(Args a) {
    extern __shared__ __attribute__((aligned(16))) unsigned char lds[];
    cg::grid_group grid = cg::this_grid();
    LAS unsigned char* ldsL = (LAS unsigned char*)lds;
    const int tid = threadIdx.x, lane = tid & 63, wave = __builtin_amdgcn_readfirstlane(tid >> 6);
    const int G = gridDim.x, bx = blockIdx.x;
    const int vcu = (G % 8 == 0) ? (bx % 8) * (G / 8) + bx / 8 : bx;
    const int gw = bx * NWAVES + wave, ngw = G * NWAVES;
    unsigned char* ws = a.ws;
    bf16_t* WIN = (bf16_t*)(ws + WS_WIN); bf16_t* WOUT = (bf16_t*)(ws + WS_WOUT); bf16_t* WUP = (bf16_t*)(ws + WS_WUP); bf16_t* WDN = (bf16_t*)(ws + WS_WDN);
    bf16_t* WMKV = (bf16_t*)(ws + WS_WMKV); bf16_t* MEMB = (bf16_t*)(ws + WS_MEMB); bf16_t* MEMKV = (bf16_t*)(ws + WS_MEMKV);
    bf16_t* XB = (bf16_t*)(ws + WS_XB); bf16_t* HB = (bf16_t*)(ws + WS_H); bf16_t* PROJ = (bf16_t*)(ws + WS_PROJ); bf16_t* MIXED = (bf16_t*)(ws + WS_MIXED);
    float* X = a.out;
    volatile LAS unsigned* MISC = (volatile LAS unsigned*)(ldsL + LDS_MISC);
    if (tid < 16) MISC[tid] = 0u;
    __syncthreads();
    const XcdBarrier bar = xcd_barrier_post((unsigned*)(ws + WS_CTL), MISC);
    float* STA = (float*)(ws + WS_STA); float* STB = (float*)(ws + WS_STB);
    float* PU_IN = (float*)(ws + WS_PUV); float* PV_IN = PU_IN + DEPTH * 16 * INW; float* PU_UP = PV_IN + DEPTH * 16 * INW; float* PV_UP = PU_UP + DEPTH * 16 * FF;
    float* U_IN = (float*)(ws + WS_UV); float* V_IN = U_IN + DEPTH * INW; float* U_UP = V_IN + DEPTH * INW; float* V_UP = U_UP + DEPTH * FF;
#ifdef PROBE_T
    unsigned long long tacc = 0, tst = 0;
#define TB(id) do { if (PROBE_T == (id)) tst = __builtin_amdgcn_s_memrealtime(); } while (0)
#define TE(id) do { if (PROBE_T == (id)) tacc += __builtin_amdgcn_s_memrealtime() - tst; } while (0)
#else
#define TB(id) do {} while (0)
#define TE(id) do {} while (0)
#endif

    {
        LAS float* scr = (LAS float*)(ldsL + wave * 16384);
        constexpr int I_IN = (DM / 64) * (INW / 32), I_OUT = (DM / 64) * (DM / 32), I_UP = (DM / 64) * (FF / 32), I_DN = (FF / 64) * (DM / 32), I_MKV = (DM / 64) * (512 / 32);
        constexpr int I_LAYER = I_IN + I_OUT + I_UP + I_DN + I_MKV;
        for (int it = gw; it < DEPTH * I_LAYER; it += ngw) {
            const int l = it / I_LAYER; int r = it % I_LAYER;
            if (r < I_IN) { transpose_item(a.w_in + (size_t)l * DM * INW, DM, INW, WIN + (size_t)l * INW * DM, 0, scr, r, lane,
                                           l ? a.ln2_g + (l - 1) * DM : a.emb_g, l ? a.ln2_b + (l - 1) * DM : a.emb_b, PU_IN + (size_t)l * 16 * INW, PV_IN + (size_t)l * 16 * INW); continue; } r -= I_IN;
            if (r < I_OUT) { transpose_item(a.w_out + (size_t)l * DM * DM, DM, DM, WOUT + (size_t)l * DM * DM, 0, scr, r, lane, nullptr, nullptr, nullptr, nullptr); continue; } r -= I_OUT;
            if (r < I_UP) { transpose_item(a.w_up + (size_t)l * DM * FF, DM, FF, WUP + (size_t)l * FF * DM, 0, scr, r, lane,
                                           a.ln1_g + l * DM, a.ln1_b + l * DM, PU_UP + (size_t)l * 16 * FF, PV_UP + (size_t)l * 16 * FF); continue; } r -= I_UP;
            if (r < I_DN) { transpose_item(a.w_down + (size_t)l * FF * DM, FF, DM, WDN + (size_t)l * DM * FF, 0, scr, r, lane, nullptr, nullptr, nullptr, nullptr); continue; } r -= I_DN;
            transpose_item(a.w_mkv + (size_t)l * DM * 512, DM, 512, WMKV, l * 512, scr, r, lane, nullptr, nullptr, nullptr, nullptr);
        }
        for (size_t i = (size_t)bx * 512 + tid; i < (size_t)MMEM * DM / 8; i += (size_t)G * 512) {
            const f32x4 v0 = ((const f32x4*)a.mem)[2 * i], v1 = ((const f32x4*)a.mem)[2 * i + 1];
            u32x4 o; o.x = cvt_pk_bf16(v0.x, v0.y); o.y = cvt_pk_bf16(v0.z, v0.w); o.z = cvt_pk_bf16(v1.x, v1.y); o.w = cvt_pk_bf16(v1.z, v1.w);
            ((u32x4*)MEMB)[i] = o;
        }
        copy_stats_phase(a.x, XB, STA, gw, ngw);
    }
    grid.sync();
    for (int i = bx * 512 + tid; i < DEPTH * (INW + FF); i += G * 512) {
        if (i < DEPTH * INW) { const int l = i / INW, n = i % INW; float su = 0.f, sv = 0.f;
            for (int kb = 0; kb < 16; ++kb) { su += PU_IN[((size_t)l * 16 + kb) * INW + n]; sv += PV_IN[((size_t)l * 16 + kb) * INW + n]; }
            U_IN[i] = su; V_IN[i] = sv + a.b_in[i]; }
        else { const int j = i - DEPTH * INW, l = j / FF, n = j % FF; float su = 0.f, sv = 0.f;
            for (int kb = 0; kb < 16; ++kb) { su += PU_UP[((size_t)l * 16 + kb) * FF + n]; sv += PV_UP[((size_t)l * 16 + kb) * FF + n]; }
            U_UP[j] = su; V_UP[j] = sv; }
    }
    {
        pg8::Gemm g{MEMB, WMKV, MMEM, DEPTH * 512, DM}; pg8::StaticOrder S; S.init(MMEM, DEPTH * 512, G, bx);
        pg8::EpiStore<0> E{MEMKV, DEPTH * 512, nullptr, nullptr, nullptr};
#ifndef SKIP_GMKV
        pg8::gemm_phase<pg8::EpiStore<0>, pg8::StaticOrder>(ldsL, g, S, E);
#endif
    }
    grid.sync();

    for (int l = 0; l < DEPTH; ++l) {
        {
            pg8::Gemm g{XB, WIN + (size_t)l * INW * DM, MTOK, INW, DM}; pg8::StaticOrder S; S.init(MTOK, INW, G, bx);
            pg8::EpiStore<1> E{PROJ, INW, STA, U_IN + l * INW, V_IN + l * INW};
            TB(5);
#ifndef SKIP_GPROJ
            pg8::gemm_phase<pg8::EpiStore<1>, pg8::StaticOrder>(ldsL, g, S, E);
#ifdef DUP_PROJ
            pg8::gemm_phase<pg8::EpiStore<1>, pg8::StaticOrder>(ldsL, g, S, E);
#endif
#endif
            TE(5);
        }
        TB(4); xcd_barrier(bar); TE(4);
#ifdef DUP_SYNC
        xcd_barrier(bar); xcd_barrier(bar); xcd_barrier(bar); xcd_barrier(bar);
#endif
#if defined(STOP_AT) && STOP_AT == 1
        return;
#endif
        {
#ifdef ATT2
            LAS float* tabs = (LAS float*)(ldsL + att::L2_TAB);
#else
            LAS float* tabs = (LAS float*)(ldsL + att::L_TAB);
#endif
            const int tidp = opaque_tid(), lanep = tidp & 63;
            for (int i = tidp; i < 4 * att::TABN; i += 512) { const int h = i / att::TABN, rel = i % att::TABN - att::TABC; tabs[i] = a.rel_bias[t5_bucket(rel) * 4 + h] * LOG2E; }
            float lam;
            { const float d1 = wave_sum(a.lq1[l * 64 + lanep] * a.lk1[l * 64 + lanep]), d2 = wave_sum(a.lq2[l * 64 + lanep] * a.lk2[l * 64 + lanep]);
              lam = expf(d1) - expf(d2) + a.lam_init[l]; }
            const float oscale = 1.f - a.lam_init[l];
            __syncthreads();
            TB(1);
#ifndef SKIP_DIFF
#ifdef DUP_DIFF
            for (int rep = 0; rep < 2; ++rep)
#endif
#ifdef ATT2
            for (int id = vcu; id < BATCH * 4 * 16; id += G) {
                const int bh = id >> 4, qb = id & 15, b = bh >> 2, h = bh & 3;
                const size_t row0 = (size_t)b * SEQ + qb * 256;
                att::attn_unit2<false>(PROJ + row0 * INW + 512 + h * 128, INW, PROJ + (size_t)b * SEQ * INW + 1024 + h * 128, PROJ + (size_t)b * SEQ * INW + 1536 + h * 128, INW,
                                       MIXED + row0 * DM + 256 + h * 128, qb * 256, tabs + h * att::TABN, lam, oscale, a.diff_g + l * 128, (char*)lds);
            }
#else
            for (int id = vcu; id < BATCH * 4 * 32; id += G) {
                const int bh = id >> 5, qb = id & 31, b = bh >> 2, h = bh & 3;
                const size_t row0 = (size_t)b * SEQ + qb * 128;
                att::attn_unit<false>(PROJ + row0 * INW + 512 + h * 128, INW, PROJ + (size_t)b * SEQ * INW + 1024 + h * 128, PROJ + (size_t)b * SEQ * INW + 1536 + h * 128, INW,
                                      MIXED + row0 * DM + 256 + h * 128, qb * 128, tabs + h * att::TABN, lam, oscale, a.diff_g + l * 128, (char*)lds);
            }
#endif
#endif
            TE(1);
            __syncthreads();
            TB(2);
#ifndef SKIP_MEMATT
#ifdef ATT2
            for (int id = vcu; id < BATCH * 2 * 16; id += G) {
                const int bp = id >> 4, qb = id & 15, b = bp >> 1, hp = bp & 1;
                const size_t row0 = (size_t)b * SEQ + qb * 256;
                att::attn_unit2<true>(PROJ + row0 * INW + 2048 + hp * 128, INW, MEMKV + (size_t)b * MEML * 2048 + l * 512 + hp * 128, MEMKV + (size_t)b * MEML * 2048 + l * 512 + 256 + hp * 128, 2048,
                                      MIXED + row0 * DM + 768 + hp * 128, 0, tabs, 0.f, 0.f, nullptr, (char*)lds);
            }
#else
            for (int id = vcu; id < BATCH * 2 * 32; id += G) {
                const int bp = id >> 5, qb = id & 31, b = bp >> 1, hp = bp & 1;
                const size_t row0 = (size_t)b * SEQ + qb * 128;
                att::attn_unit<true>(PROJ + row0 * INW + 2048 + hp * 128, INW, MEMKV + (size_t)b * MEML * 2048 + l * 512 + hp * 128, MEMKV + (size_t)b * MEML * 2048 + l * 512 + 256 + hp * 128, 2048,
                                     MIXED + row0 * DM + 768 + hp * 128, 0, tabs, 0.f, 0.f, nullptr, (char*)lds);
            }
#ifdef DUP_MISC
            __syncthreads();
            for (int id = vcu; id < BATCH * 2 * 32; id += G) {
                const int bp = id >> 5, qb = id & 31, b = bp >> 1, hp = bp & 1;
                const size_t row0 = (size_t)b * SEQ + qb * 128;
                att::attn_unit<true>(PROJ + row0 * INW + 2048 + hp * 128, INW, MEMKV + (size_t)b * MEML * 2048 + l * 512 + hp * 128, MEMKV + (size_t)b * MEML * 2048 + l * 512 + 256 + hp * 128, 2048,
                                     MIXED + row0 * DM + 768 + hp * 128, 0, tabs, 0.f, 0.f, nullptr, (char*)lds);
            }
#endif
#endif
#endif
            TE(2);
            __syncthreads();
            TB(3);
#ifndef SKIP_CONV
            for (int id = bx; id < MTOK / 32; id += G)
                conv_unit(PROJ, MIXED, a.conv_w + l * CONVW * CONVC, a.conv_b + l * CONVC, a.conv_ln_g + l * CONVC, a.conv_ln_b + l * CONVC, id, (LAS float*)ldsL);
#ifdef DUP_MISC
            for (int id = bx; id < MTOK / 32; id += G)
                conv_unit(PROJ, MIXED, a.conv_w + l * CONVW * CONVC, a.conv_b + l * CONVC, a.conv_ln_g + l * CONVC, a.conv_ln_b + l * CONVC, id, (LAS float*)ldsL);
#endif
#endif
            TE(3);
        }
        TB(4); xcd_barrier(bar); TE(4);
#ifdef DUP_SYNC
        xcd_barrier(bar); xcd_barrier(bar); xcd_barrier(bar); xcd_barrier(bar);
#endif
#if defined(STOP_AT) && STOP_AT == 2
        return;
#endif
        {
            pg8::Gemm g{MIXED, WOUT + (size_t)l * DM * DM, MTOK, DM, DM}; pg8::StaticOrder S; S.init(MTOK, DM, G, bx);
            pg8::EpiResid E{XB, STA, l ? a.ln2_g + (l - 1) * DM : a.emb_g, l ? a.ln2_b + (l - 1) * DM : a.emb_b, STB, a.b_out + l * DM};
            TB(6);
#ifndef SKIP_GOUT
            pg8::gemm_phase<pg8::EpiResid, pg8::StaticOrder>(ldsL, g, S, E);
#endif
            TE(6);
        }
        TB(4); xcd_barrier(bar); TE(4);
#ifdef DUP_SYNC
        xcd_barrier(bar); xcd_barrier(bar); xcd_barrier(bar); xcd_barrier(bar);
#endif
#if defined(STOP_AT) && STOP_AT == 3
        return;
#endif
        {
            pg8::Gemm g{XB, WUP + (size_t)l * FF * DM, MTOK, FF, DM}; pg8::StaticOrder S; S.init(MTOK, FF, G, bx);
            pg8::EpiStore<2> E{HB, FF, STB, U_UP + l * FF, V_UP + l * FF};
            TB(7);
#ifndef SKIP_GUP
            pg8::gemm_phase<pg8::EpiStore<2>, pg8::StaticOrder>(ldsL, g, S, E);
#ifdef DUP_UP
            pg8::gemm_phase<pg8::EpiStore<2>, pg8::StaticOrder>(ldsL, g, S, E);
#endif
#endif
            TE(7);
        }
        TB(4); xcd_barrier(bar); TE(4);
#ifdef DUP_SYNC
        xcd_barrier(bar); xcd_barrier(bar); xcd_barrier(bar); xcd_barrier(bar);
#endif
        {
            pg8::Gemm g{HB, WDN + (size_t)l * DM * FF, MTOK, DM, FF}; pg8::StaticOrder S; S.init(MTOK, DM, G, bx);
            pg8::EpiResid E{XB, STB, a.ln1_g + l * DM, a.ln1_b + l * DM, STA, nullptr};
            TB(8);
#ifndef SKIP_GDOWN
            pg8::gemm_phase<pg8::EpiResid, pg8::StaticOrder>(ldsL, g, S, E);
#endif
            TE(8);
        }
        TB(4); xcd_barrier(bar); TE(4);
#ifdef DUP_SYNC
        xcd_barrier(bar); xcd_barrier(bar); xcd_barrier(bar); xcd_barrier(bar);
#endif
    }
    ln_final_phase(XB, STA, a.ln2_g + (DEPTH - 1) * DM, a.ln2_b + (DEPTH - 1) * DM, X, gw, ngw);
#ifdef PROBE_T
    if (bx == 0 && tid == 0) X[0] = (float)tacc * 0.01f;
#endif
}

extern "C" void kernel_launch(void* const* d_in, const int* in_sizes, int n_in, void* d_out, int out_size, void* d_ws, size_t ws_size, hipStream_t stream) {
    static int grid = 0;
    if (grid == 0) {
        if (n_in != 25 || in_sizes[0] != MTOK * DM || out_size != MTOK * DM || ws_size < WS_END) {
            fprintf(stderr, "kernel_launch: unexpected shapes: n_in %d in0 %d out %d ws %zu (need >= %zu)\n", n_in, n_in > 0 ? in_sizes[0] : -1, out_size, ws_size, (size_t)WS_END); grid = -1; return; }
        int dev = 0, cus = 0, per_cu = 0;
        if (hipGetDevice(&dev) != hipSuccess || hipDeviceGetAttribute(&cus, hipDeviceAttributeMultiprocessorCount, dev) != hipSuccess) { fprintf(stderr, "kernel_launch: device query failed\n"); grid = -1; return; }
        if (hipFuncSetAttribute((const void*)mk_fwd, hipFuncAttributeMaxDynamicSharedMemorySize, LDS_BYTES) != hipSuccess) { fprintf(stderr, "kernel_launch: hipFuncSetAttribute failed\n"); grid = -1; return; }
        if (hipOccupancyMaxActiveBlocksPerMultiprocessor(&per_cu, (const void*)mk_fwd, NWAVES * 64, LDS_BYTES) != hipSuccess || per_cu < 1) { fprintf(stderr, "kernel_launch: occupancy query says %d\n", per_cu); per_cu = 1; }
        (void)hipGetLastError();
        grid = cus * per_cu;
    }
    if (grid < 0) return;
    if (hipMemsetAsync((char*)d_ws + WS_CTL, 0, CTL_BYTES, stream) != hipSuccess) { fprintf(stderr, "kernel_launch: memset of the barrier words failed\n"); return; }
    Args a{};
    const float** f = (const float**)&a;
    for (int i = 0; i < 25; ++i) f[i] = (const float*)d_in[i];
    a.out = (float*)d_out; a.ws = (unsigned char*)d_ws;
    for (int l = 0; l < 4; ++l) a.lam_init[l] = (float)(0.8 - 0.6 * std::exp(-0.3 * (double)l));
    void* args[] = {&a};
    hipError_t e = hipLaunchCooperativeKernel((const void*)mk_fwd, dim3(grid), dim3(NWAVES * 64), args, LDS_BYTES, stream);
    if (e != hipSuccess) { fprintf(stderr, "kernel_launch: cooperative launch failed: %s (grid %d)\n", hipGetErrorString(e), grid); (void)hipGetLastError(); (void)hipMemsetAsync(d_out, 0, (size_t)out_size * 4, stream); }
}
```
